# Optimizing an MI355X kernel written in HIP

```python
import jax, jax.numpy as jnp
from jax import lax
import numpy as np

D_MODEL = 1024
BATCH = 8
SEQ = 2048
DEPTH = 2

HEAD_DIM = 64
A_HEADS = 8
A_KV_HEADS = 2
B_HEADS = 8
B_KV_HEADS = 2
IDX_HEADS = 8
IDX_DIM = 64
WINDOW = 128
BLOCK = 128
TOPK_MAX = 256
ROPE_THETA = 10000.0
D_FF = ((-(-8 * D_MODEL // 3)) + 255) // 256 * 256
ALPHA = (2.0 * DEPTH) ** 0.25
BETA = (8.0 * DEPTH) ** -0.25

A_Q = A_HEADS * HEAD_DIM
A_KV = A_KV_HEADS * HEAD_DIM
B_Q = B_HEADS * HEAD_DIM
B_KV = B_KV_HEADS * HEAD_DIM
I_Q = IDX_HEADS * IDX_DIM
I_K = IDX_DIM
I_W = IDX_HEADS
_PIECES = [A_Q, A_KV, A_KV, B_Q, B_KV, B_KV, I_Q, I_K]
SPLITS = [int(v) for v in np.cumsum(_PIECES)]
D_IN = SPLITS[-1] + I_W

kernel_name = "hybrid_swa_sink_dsa_deepnorm_adaln"


def layer_norm(x, g, b, eps=1e-5):
    xf = x.astype(jnp.float32)
    mu = jnp.mean(xf, -1, keepdims=True)
    var = jnp.mean(jnp.square(xf - mu), -1, keepdims=True)
    return ((xf - mu) * lax.rsqrt(var + eps) * g.astype(jnp.float32) + b.astype(jnp.float32)).astype(x.dtype)


def rms_norm(x, g, eps=1e-6):
    xf = x.astype(jnp.float32)
    ms = jnp.mean(jnp.square(xf), -1, keepdims=True)
    return (xf * lax.rsqrt(ms + eps) * g.astype(jnp.float32)).astype(x.dtype)


def rope(x, pos):
    half = x.shape[-1] // 2
    inv = ROPE_THETA ** (-jnp.arange(half, dtype=jnp.float32) / half)
    ang = pos.astype(jnp.float32)[..., None] * inv
    cos = jnp.cos(ang)[:, :, None, :]
    sin = jnp.sin(ang)[:, :, None, :]
    xf = x.astype(jnp.float32)
    x1, x2 = xf[..., :half], xf[..., half:]
    return jnp.concatenate([x1 * cos - x2 * sin, x2 * cos + x1 * sin], -1).astype(x.dtype)


def swa_with_sinks(q, k, v, sinks):
    B, S, H, D = q.shape
    KVH = k.shape[2]
    G = H // KVH
    nb = S // BLOCK
    qb = q.reshape(B, nb, BLOCK, KVH, G, D)
    kb = k.reshape(B, nb, BLOCK, KVH, D)
    vb = v.reshape(B, nb, BLOCK, KVH, D)
    pad = jnp.zeros_like(kb[:, :1])
    kk = jnp.concatenate([jnp.concatenate([pad, kb[:, :-1]], 1), kb], axis=2)
    vv = jnp.concatenate([jnp.concatenate([pad, vb[:, :-1]], 1), vb], axis=2)
    s = jnp.einsum('bnqhgd,bnkhd->bnhgqk', qb, kk).astype(jnp.float32) * (D ** -0.5)
    qi = jnp.arange(BLOCK)[:, None]
    kj = jnp.arange(2 * BLOCK)[None, :]
    delta = BLOCK + qi - kj
    band = (delta >= 0) & (delta < WINDOW)
    has_prev = (jnp.arange(nb) > 0)[:, None, None] | (kj >= BLOCK)[None]
    mask = band[None] & has_prev
    s = jnp.where(mask[None, :, None, None], s, -jnp.inf)
    sink = jnp.broadcast_to(sinks.astype(jnp.float32).reshape(1, 1, KVH, G, 1, 1), s.shape[:-1] + (1,))
    p = jax.nn.softmax(jnp.concatenate([s, sink], -1), axis=-1)[..., :-1].astype(v.dtype)
    o = jnp.einsum('bnhgqk,bnkhd->bnqhgd', p, vv)
    return o.reshape(B, S, H * D)


def dsa_sparse_attention(q, k, v, qi, ki, wi):
    B, S, H, D = q.shape
    KVH = k.shape[2]
    G = H // KVH
    nb = S // BLOCK
    topk = min(TOPK_MAX, S // 4)
    w_scaled = wi.astype(jnp.float32) * (IDX_HEADS ** -0.5 * IDX_DIM ** -0.5)
    bidx = jnp.arange(B)[:, None, None]
    key_pos = jnp.arange(S)

    def to_blocks(a):
        return a.reshape((B, nb, BLOCK) + a.shape[2:]).swapaxes(0, 1)

    def one_block(args):
        qb, qib, wb, n = args
        t = n * BLOCK + jnp.arange(BLOCK)
        rel = jax.nn.relu(jnp.einsum('bqhd,bsd->bqhs', qib, ki).astype(jnp.float32))
        score = jnp.einsum('bqhs,bqh->bqs', rel, wb)
        causal = key_pos[None, :] <= t[:, None]
        score = jnp.where(causal[None], score, -jnp.inf)
        _, sel = lax.top_k(score, topk)
        ks = k[bidx, sel]
        vs = v[bidx, sel]
        qg = qb.reshape(B, BLOCK, KVH, G, D)
        s = jnp.einsum('bqhgd,bqnhd->bqhgn', qg, ks).astype(jnp.float32) * (D ** -0.5)
        valid = (sel <= t[None, :, None])[:, :, None, None, :]
        s = jnp.where(valid, s, -jnp.inf)
        p = jax.nn.softmax(s, axis=-1).astype(v.dtype)
        o = jnp.einsum('bqhgn,bqnhd->bqhgd', p, vs)
        return o.reshape(B, BLOCK, H * D)

    out = lax.map(one_block, (to_blocks(q), to_blocks(qi), to_blocks(w_scaled), jnp.arange(nb)))
    return out.swapaxes(0, 1).reshape(B, S, H * D)


def hybrid_mixer(h, pos, w_in, sinks, g_a, g_b, w_o):
    B, S, _ = h.shape
    proj = h @ w_in
    qa, ka, va, qb, kb, vb, qi, ki, wi = jnp.split(proj, SPLITS, axis=-1)

    def heads(a, n):
        return a.reshape(B, S, n, -1)

    qa = rope(heads(qa, A_HEADS), pos)
    ka = rope(heads(ka, A_KV_HEADS), pos)
    va = heads(va, A_KV_HEADS)
    qb = rope(heads(qb, B_HEADS), pos)
    kb = rope(heads(kb, B_KV_HEADS), pos)
    vb = heads(vb, B_KV_HEADS)
    qi = rope(heads(qi, IDX_HEADS), pos)
    ki = rope(ki[:, :, None, :], pos)[:, :, 0, :]
    ya = swa_with_sinks(qa, ka, va, sinks)
    yb = dsa_sparse_attention(qb, kb, vb, qi, ki, wi)
    y = jnp.concatenate([rms_norm(ya, g_a), rms_norm(yb, g_b)], -1)
    return y @ w_o


def swiglu(h, w_gate, w_up, w_down):
    return (jax.nn.silu(h @ w_gate) * (h @ w_up)) @ w_down


def setup_inputs(seed: int = 0) -> dict:
    key = jax.random.key(seed)
    ks = jax.random.split(key, 20)
    f32 = jnp.float32
    nrm = lambda k, shape, s: jax.random.normal(k, shape, f32) * s
    x = nrm(ks[0], (BATCH, SEQ, D_MODEL), 1.0)
    c = nrm(ks[1], (BATCH, D_MODEL), 1.0)
    offset = jax.random.randint(ks[2], (BATCH, 1), 0, 1024, dtype=jnp.int32)
    positions = offset + jnp.arange(SEQ, dtype=jnp.int32)[None, :]
    w_ada = nrm(ks[3], (DEPTH, D_MODEL, 6 * D_MODEL), 0.5 * D_MODEL ** -0.5)
    b_ada = nrm(ks[4], (DEPTH, 6 * D_MODEL), 0.01)
    col_scale = np.ones((D_IN,), np.float32)
    col_scale[SPLITS[1]:SPLITS[2]] = BETA
    col_scale[SPLITS[4]:SPLITS[5]] = BETA
    w_in = nrm(ks[5], (DEPTH, D_MODEL, D_IN), D_MODEL ** -0.5) * jnp.asarray(col_scale)
    attn_sinks = nrm(ks[6], (DEPTH, A_HEADS), 1.0)
    g_a = 1.0 + nrm(ks[7], (DEPTH, A_Q), 0.02)
    g_b = 1.0 + nrm(ks[8], (DEPTH, B_Q), 0.02)
    w_o = nrm(ks[9], (DEPTH, A_Q + B_Q, D_MODEL), BETA * (A_Q + B_Q) ** -0.5)
    ln1_g = 1.0 + nrm(ks[10], (DEPTH, D_MODEL), 0.02)
    ln1_b = nrm(ks[11], (DEPTH, D_MODEL), 0.02)
    w_gate = nrm(ks[12], (DEPTH, D_MODEL, D_FF), D_MODEL ** -0.5)
    w_up = nrm(ks[13], (DEPTH, D_MODEL, D_FF), D_MODEL ** -0.5)
    w_down = nrm(ks[14], (DEPTH, D_FF, D_MODEL), BETA * D_FF ** -0.5)
    ln2_g = 1.0 + nrm(ks[15], (DEPTH, D_MODEL), 0.02)
    ln2_b = nrm(ks[16], (DEPTH, D_MODEL), 0.02)
    return {"x": x, "c": c, "positions": positions, "w_ada": w_ada, "b_ada": b_ada,
            "w_in": w_in, "attn_sinks": attn_sinks, "g_a": g_a, "g_b": g_b, "w_o": w_o,
            "ln1_g": ln1_g, "ln1_b": ln1_b, "w_gate": w_gate, "w_up": w_up, "w_down": w_down,
            "ln2_g": ln2_g, "ln2_b": ln2_b}


def reference(x, c, positions, w_ada, b_ada, w_in, attn_sinks, g_a, g_b, w_o,
              ln1_g, ln1_b, w_gate, w_up, w_down, ln2_g, ln2_b):
    c_act = jax.nn.silu(c)
    for l in range(DEPTH):
        mod = (c_act @ w_ada[l] + b_ada[l])[:, None, :]
        sh1, sc1, gt1, sh2, sc2, gt2 = jnp.split(mod, 6, axis=-1)
        h = x * (1.0 + sc1) + sh1
        y = hybrid_mixer(h, positions, w_in[l], attn_sinks[l], g_a[l], g_b[l], w_o[l])
        x = layer_norm(ALPHA * x + (1.0 + gt1) * y, ln1_g[l], ln1_b[l])
        h = x * (1.0 + sc2) + sh2
        y = swiglu(h, w_gate[l], w_up[l], w_down[l])
        x = layer_norm(ALPHA * x + (1.0 + gt2) * y, ln2_g[l], ln2_b[l])
    return x
```

```cpp
#include <hip/hip_runtime.h>
#include <hip/hip_cooperative_groups.h>
#include <cstdio>
#include <cstdint>
#include <cmath>
namespace cg = cooperative_groups;

constexpr int BATCH = 8, SEQ = 2048, DM = 1024, DEPTH = 2, MTOK = BATCH * SEQ;
constexpr int HD = 64, DFF = 2816, NIN = 2120, NINP = 2304, NGU = 2 * DFF;
constexpr int TOPK = 256;
constexpr float ALPHA = 1.4142135623730951f;
constexpr float LOG2E = 1.4426950408889634f;
constexpr float QSCALE = 0.125f * LOG2E;

typedef _Float16 f16;
typedef _Float16 f16x2 __attribute__((ext_vector_type(2)));
typedef _Float16 f16x4 __attribute__((ext_vector_type(4)));
typedef _Float16 f16x8 __attribute__((ext_vector_type(8)));
typedef unsigned short h16_t;
typedef short s16x8 __attribute__((ext_vector_type(8)));
typedef float f32x4 __attribute__((ext_vector_type(4)));
typedef float f32x2 __attribute__((ext_vector_type(2)));
typedef unsigned u32x4 __attribute__((ext_vector_type(4)));
typedef unsigned u32x2 __attribute__((ext_vector_type(2)));
#define LAS __attribute__((address_space(3)))
#define TIDX(ws_) ((ws_) * 64 + (int)__builtin_amdgcn_mbcnt_hi(~0u, __builtin_amdgcn_mbcnt_lo(~0u, 0u)))

constexpr size_t MiB = 1u << 20;
constexpr size_t WS_CTL = 0;
constexpr size_t WS_MOD = 1 * MiB;
constexpr size_t WS_ROPE = 2 * MiB;
constexpr size_t WS_W = 6 * MiB;
constexpr size_t W_LAYER = 23 * MiB, W_IN = 0, W_O = (size_t)NINP * DM * 2, W_GU = W_O + (size_t)DM * DM * 2, W_D = W_GU + (size_t)NGU * DM * 2;
constexpr size_t WS_H = 52 * MiB;
constexpr size_t WS_MASK = 84 * MiB;
constexpr size_t WS_QKV = 88 * MiB;
constexpr size_t O_QA = 0, O_KA = O_QA + (size_t)MTOK * 512 * 2, O_VA = O_KA + (size_t)MTOK * 128 * 2, O_QB = O_VA + (size_t)MTOK * 128 * 2,
                 O_KB = O_QB + (size_t)MTOK * 512 * 2, O_VB = O_KB + (size_t)MTOK * 128 * 2, O_QI = O_VB + (size_t)MTOK * 128 * 2,
                 O_KI = O_QI + (size_t)MTOK * 512 * 2, O_WI = O_KI + (size_t)MTOK * 64 * 2, O_Y = O_WI + (size_t)MTOK * 8 * 4, O_END = O_Y + (size_t)MTOK * DM * 2;
constexpr size_t WS_END = WS_QKV + O_END;
static_assert(W_D + (size_t)DM * DFF * 2 <= W_LAYER, "weights per layer");
static_assert(WS_W + DEPTH * W_LAYER <= WS_H, "ws map");
static_assert((size_t)MTOK * DFF * 2 <= O_END, "ACT overlay fits");
static_assert(WS_END <= 256 * MiB, "workspace");

namespace pg8 {
constexpr int BM = 256, BK = 64, HALF = 128, HTB = HALF * BK * 2, STAGE_BYTES = 8 * HTB, NXCD = 8, WGM = 8;
__host__ __device__ __forceinline__ int lds_byte(int r, int c) { const int st = (r >> 4) * 2 + (c >> 5), rr = r & 15, cc = c & 31, ob = rr * 64 + cc * 2; return st * 1024 + (ob ^ (((ob >> 9) & 1) << 5)); }
__host__ __device__ __forceinline__ void stage_rc(int b, int& R, int& C) { const int st = b / 1024, sb = b % 1024, swz = sb ^ (((sb >> 9) & 1) << 5); R = (st >> 1) * 16 + swz / 64; C = (st & 1) * 32 + (swz % 64) / 2; }
__host__ __device__ __forceinline__ int perm32(int rho) { const int n = rho >> 4, i = rho & 15; return 8 * (i >> 2) + 4 * n + (i & 3); }
struct Unit { int pm, pn; };
struct Gemm { const h16_t* A; const h16_t* Bt; int M, N, K; };
struct StaticOrder {
    int nM, nN, nwg, G, c;
    __host__ __device__ void init(int M, int N, int G_, int c_) { nM = M / BM; nN = N / BM; nwg = nM * nN; G = G_; c = c_; }
    __host__ __device__ bool next(int i, Unit& u) const {
        const long L = (long)i * G + c; if (L >= nwg) return false;
        int wgid = (int)L; { const int q = nwg / NXCD, r = nwg % NXCD, xcd = wgid % NXCD, off = wgid / NXCD; wgid = (xcd < r ? xcd * (q + 1) : r * (q + 1) + (xcd - r) * q) + off; }
        const int nig = WGM * nN, gid = wgid / nig, fm = gid * WGM, gsz = (nM - fm) < WGM ? (nM - fm) : WGM;
        u.pm = fm + ((wgid % nig) % gsz); u.pn = (wgid % nig) / gsz; return true;
    }
    __device__ __forceinline__ void a_ready(const Unit&) const {}
    __device__ __forceinline__ void done(const Unit&) const {}
};

template <class Epi, class Sched, bool ALIGN_EPI = false, bool SP2 = false>
__device__ __forceinline__ void gemm_phase(LAS unsigned char* lds, const Gemm g, const Sched& S, const Epi& E, const int wave_s) {
    const int tid = TIDX(wave_s), wid = wave_s, lane = tid & 63, wr = wid >> 2, wc = wid & 3, fr = lane & 15, fq = lane >> 4;
    const int K = g.K, nt = K / BK;
    unsigned voffA[2], voffB[2];
#pragma unroll
    for (int i = 0; i < 2; ++i) { int R, C; stage_rc(tid * 16 + i * 8192, R, C); const int Rb = Epi::PERM ? ((R & ~31) + perm32(R & 31)) : R;
        voffA[i] = (unsigned)(R * K + C) * 2u; voffB[i] = (unsigned)(Rb * K + C) * 2u; }
    const size_t kstep = (size_t)(BK * 2);
    const size_t hstep = (size_t)HALF * K * 2;
    const size_t tstep = 2 * hstep;
    const unsigned ldsw = (unsigned)wid * 1024u;
    const int aoff = lds_byte(wr * 64 + fr, fq * 8), boff = lds_byte(wc * 32 + fr, fq * 8);
#define PG8_SA(b, h) (((b) * 2 + (h)) * HTB)
#define PG8_SB(b, h) ((4 + (b) * 2 + (h)) * HTB)
#define PG8_STAGE(bufoff, gbase, voff) do { _Pragma("unroll") for (int _i = 0; _i < 2; ++_i) \
        __builtin_amdgcn_global_load_lds((const unsigned*)((const char*)(gbase) + (voff)[_i]), (LAS unsigned*)(lds + (bufoff) + ldsw + _i * 8192), 16, 0, 0); } while (0)
#define PG8_LDA(dst, b, h) do { _Pragma("unroll") for (int m = 0; m < 4; ++m) _Pragma("unroll") for (int k = 0; k < 2; ++k) dst[m][k] = *(const LAS s16x8*)(lds + PG8_SA(b, h) + aoff + m * 2048 + k * 1024); } while (0)
#define PG8_LDB(dst, b, h) do { _Pragma("unroll") for (int n = 0; n < 2; ++n) _Pragma("unroll") for (int k = 0; k < 2; ++k) dst[n][k] = *(const LAS s16x8*)(lds + PG8_SB(b, h) + boff + n * 2048 + k * 1024); } while (0)
#define PG8_MMA(ai, bj, At, Bt) do { __builtin_amdgcn_s_setprio(1); _Pragma("unroll") for (int m = 0; m < 4; ++m) _Pragma("unroll") for (int n = 0; n < 2; ++n) _Pragma("unroll") for (int k = 0; k < 2; ++k) \
        acc[ai][bj][m][n] = __builtin_amdgcn_mfma_f32_16x16x32_f16(__builtin_bit_cast(f16x8, Bt[n][k]), __builtin_bit_cast(f16x8, At[m][k]), acc[ai][bj][m][n], 0, 0, 0); __builtin_amdgcn_s_setprio(0); } while (0)
#define PG8_WAIT_V(n) asm volatile("s_waitcnt vmcnt(" #n ")" ::: "memory")
#define PG8_WAIT_L(n) asm volatile("s_waitcnt lgkmcnt(" #n ")" ::: "memory")
#define PG8_BAR __builtin_amdgcn_s_barrier()
#define PG8_SCHED __builtin_amdgcn_sched_barrier(0)
    Unit cur, nxt; int ui = 0;
    if (!S.next(0, cur)) return;
    f32x4 acc[2][2][4][2];
#pragma unroll
    for (int a = 0; a < 2; ++a)
#pragma unroll
        for (int b = 0; b < 2; ++b)
#pragma unroll
            for (int m = 0; m < 4; ++m)
#pragma unroll
                for (int n = 0; n < 2; ++n) acc[a][b][m][n] = (f32x4){0.f, 0.f, 0.f, 0.f};
    s16x8 At[4][2], B0[2][2], B1[2][2];
    const char* cA = (const char*)g.A + (size_t)cur.pm * tstep; const char* cB = (const char*)g.Bt + (size_t)cur.pn * tstep;
    S.a_ready(cur);
    if constexpr (SP2) {
        PG8_STAGE(PG8_SB(0, 0), cB, voffB); PG8_STAGE(PG8_SB(0, 1), cB + hstep, voffB); PG8_STAGE(PG8_SA(0, 0), cA, voffA); PG8_STAGE(PG8_SA(0, 1), cA + hstep, voffA);
        if (wr == 1) PG8_BAR;
        PG8_WAIT_V(2); PG8_BAR;
        PG8_STAGE(PG8_SB(1, 0), cB + kstep, voffB); PG8_STAGE(PG8_SA(1, 0), cA + kstep, voffA); PG8_STAGE(PG8_SB(1, 1), cB + hstep + kstep, voffB);
        PG8_WAIT_V(6); PG8_BAR;
    } else {
        PG8_STAGE(PG8_SB(0, 0), cB, voffB); PG8_STAGE(PG8_SA(0, 0), cA, voffA); PG8_STAGE(PG8_SB(0, 1), cB + hstep, voffB); PG8_STAGE(PG8_SA(0, 1), cA + hstep, voffA);
        if (wr == 1) PG8_BAR;
        PG8_WAIT_V(4); PG8_BAR;
        PG8_STAGE(PG8_SB(1, 0), cB + kstep, voffB); PG8_STAGE(PG8_SA(1, 0), cA + kstep, voffA); PG8_STAGE(PG8_SB(1, 1), cB + hstep + kstep, voffB);
        PG8_WAIT_V(6); PG8_BAR;
    }
    for (;;) {
        const bool has_next = S.next(ui + 1, nxt);
        const char* nA = has_next ? (const char*)g.A + (size_t)nxt.pm * tstep : cA; const char* nB = has_next ? (const char*)g.Bt + (size_t)nxt.pn * tstep : cB;
        for (int t = 0; t < nt; t += 2) {
            const bool last = (t == nt - 2);
            const char* a1 = cA + (size_t)(t + 1) * kstep;
            const char* a2 = last ? nA : cA + (size_t)(t + 2) * kstep; const char* b2 = last ? nB : cB + (size_t)(t + 2) * kstep;
            const char* a3 = a2 + kstep; const char* b3 = b2 + kstep;
            if (last && has_next) S.a_ready(nxt);
            if constexpr (SP2) {
            PG8_LDB(B0, 0, 0); PG8_LDB(B1, 0, 1); PG8_SCHED; PG8_LDA(At, 0, 0); PG8_STAGE(PG8_SA(1, 1), a1 + hstep, voffA);
            PG8_WAIT_V(8); PG8_WAIT_L(0); PG8_BAR; PG8_MMA(0, 0, At, B0); PG8_MMA(0, 1, At, B1); PG8_BAR; PG8_SCHED;
            PG8_LDA(At, 0, 1); PG8_STAGE(PG8_SB(0, 0), b2, voffB); PG8_STAGE(PG8_SB(0, 1), b2 + hstep, voffB); PG8_STAGE(PG8_SA(0, 0), a2, voffA);
            PG8_WAIT_V(8); PG8_WAIT_L(0); PG8_BAR; PG8_MMA(1, 0, At, B0); PG8_MMA(1, 1, At, B1); PG8_BAR; PG8_SCHED;
            PG8_LDB(B0, 1, 0); PG8_LDB(B1, 1, 1); PG8_SCHED; PG8_LDA(At, 1, 0); PG8_STAGE(PG8_SA(0, 1), a2 + hstep, voffA);
            PG8_WAIT_V(8); PG8_WAIT_L(0); PG8_BAR; PG8_MMA(0, 0, At, B0); PG8_MMA(0, 1, At, B1); PG8_BAR; PG8_SCHED;
            PG8_LDA(At, 1, 1); PG8_STAGE(PG8_SB(1, 0), b3, voffB); PG8_STAGE(PG8_SB(1, 1), b3 + hstep, voffB); PG8_STAGE(PG8_SA(1, 0), a3, voffA);
            PG8_WAIT_V(8); PG8_WAIT_L(0); PG8_BAR; PG8_MMA(1, 0, At, B0); PG8_MMA(1, 1, At, B1); PG8_BAR; PG8_SCHED;
            } else {
            PG8_LDB(B0, 0, 0); PG8_SCHED; PG8_LDA(At, 0, 0); PG8_STAGE(PG8_SA(1, 1), a1 + hstep, voffA);
            PG8_WAIT_L(8); PG8_BAR; PG8_WAIT_L(0); PG8_MMA(0, 0, At, B0); PG8_BAR; PG8_SCHED;
            PG8_LDB(B1, 0, 1); PG8_STAGE(PG8_SB(0, 0), b2, voffB);
            PG8_BAR; PG8_WAIT_L(0); PG8_MMA(0, 1, At, B1); PG8_BAR;
            PG8_LDA(At, 0, 1); PG8_STAGE(PG8_SA(0, 0), a2, voffA);
            PG8_BAR; PG8_WAIT_L(0); PG8_MMA(1, 0, At, B0); PG8_BAR; PG8_SCHED;
            PG8_STAGE(PG8_SB(0, 1), b2 + hstep, voffB);
            PG8_WAIT_V(6); PG8_BAR; PG8_MMA(1, 1, At, B1); PG8_BAR;
            PG8_LDB(B0, 1, 0); PG8_SCHED; PG8_LDA(At, 1, 0); PG8_STAGE(PG8_SA(0, 1), a2 + hstep, voffA);
            PG8_WAIT_L(8); PG8_BAR; PG8_WAIT_L(0); PG8_MMA(0, 0, At, B0); PG8_BAR; PG8_SCHED;
            PG8_LDB(B1, 1, 1); PG8_STAGE(PG8_SB(1, 0), b3, voffB);
            PG8_BAR; PG8_WAIT_L(0); PG8_MMA(0, 1, At, B1); PG8_BAR;
            PG8_LDA(At, 1, 1); PG8_STAGE(PG8_SA(1, 0), a3, voffA);
            PG8_BAR; PG8_WAIT_L(0); PG8_MMA(1, 0, At, B0); PG8_BAR; PG8_SCHED;
            PG8_STAGE(PG8_SB(1, 1), b3 + hstep, voffB);
            PG8_WAIT_V(6); PG8_BAR; PG8_MMA(1, 1, At, B1); PG8_BAR;
            }
        }
        if constexpr (ALIGN_EPI) { if (wr == 0) PG8_BAR; }
        if constexpr (!Epi::AFTER_DRAIN) { E(acc, cur, wr, wc, fr, fq); S.done(cur); }
        if (!has_next) break;
#pragma unroll
        for (int a = 0; a < 2; ++a)
#pragma unroll
            for (int b = 0; b < 2; ++b)
#pragma unroll
                for (int m = 0; m < 4; ++m)
#pragma unroll
                    for (int n = 0; n < 2; ++n) acc[a][b][m][n] = (f32x4){0.f, 0.f, 0.f, 0.f};
        cur = nxt; cA = nA; cB = nB; ++ui;
        if constexpr (ALIGN_EPI) { if (wr == 1) PG8_BAR; }
    }
    PG8_WAIT_V(0);
    if constexpr (!ALIGN_EPI) { if (wr == 0) PG8_BAR; }
    PG8_BAR;
    if constexpr (Epi::AFTER_DRAIN) { E.fused(acc, cur, wr, wc, fr, fq, lds, wid, lane); S.done(cur); }
#undef PG8_SA
#undef PG8_SB
#undef PG8_STAGE
#undef PG8_LDA
#undef PG8_LDB
#undef PG8_MMA
#undef PG8_WAIT_V
#undef PG8_WAIT_L
#undef PG8_BAR
#undef PG8_SCHED
}
}

__device__ __forceinline__ f16x4 cvt4(f32x4 v) { return (f16x4){(f16)v[0], (f16)v[1], (f16)v[2], (f16)v[3]}; }

struct EpiRope {
    static constexpr bool PERM = false, AFTER_DRAIN = false;
    f16 *qa, *ka, *va, *qb, *kb, *vb, *qi, *ki; float* wi; const float* cs;
    __device__ __forceinline__ void operator()(const f32x4 (&acc)[2][2][4][2], const pg8::Unit& u, int wr, int wc, int fr, int fq) const {
        const int grp = wc & 1, d0 = 16 * grp + 4 * fq;
#pragma unroll
        for (int ai = 0; ai < 2; ++ai)
#pragma unroll
            for (int m = 0; m < 4; ++m) {
                const int row = u.pm * 256 + ai * 128 + wr * 64 + m * 16 + fr;
                const f32x4* cp = (const f32x4*)(cs + ((size_t)row * 32 + d0) * 2);
                const f32x4 c01 = cp[0], c23 = cp[1];
                const float co[4] = {c01[0], c01[2], c23[0], c23[2]}, si[4] = {c01[1], c01[3], c23[1], c23[3]};
#pragma unroll
                for (int bj = 0; bj < 2; ++bj) {
                    const int cb = u.pn * 256 + bj * 128 + wc * 32, hb = cb >> 6;
                    const f32x4 a0 = acc[ai][bj][m][0], a1 = acc[ai][bj][m][1];
                    if (hb >= 34) continue;
                    if (hb == 33) { if (grp == 0 && fq < 2) *(f32x4*)(wi + (size_t)row * 8 + 4 * fq) = a0; continue; }
                    f16* dst; int pitch, col; bool rope = true; float sc = 1.f;
                    if (hb < 8) { dst = qa; pitch = 512; col = hb * 64; sc = QSCALE; }
                    else if (hb < 10) { dst = ka; pitch = 128; col = (hb - 8) * 64; }
                    else if (hb < 12) { dst = va; pitch = 128; col = (hb - 10) * 64; rope = false; }
                    else if (hb < 20) { dst = qb; pitch = 512; col = (hb - 12) * 64; sc = QSCALE; }
                    else if (hb < 22) { dst = kb; pitch = 128; col = (hb - 20) * 64; }
                    else if (hb < 24) { dst = vb; pitch = 128; col = (hb - 22) * 64; rope = false; }
                    else if (hb < 32) { dst = qi; pitch = 512; col = (hb - 24) * 64; }
                    else { dst = ki; pitch = 64; col = 0; }
                    f32x4 o0, o1;
                    if (rope) {
#pragma unroll
                        for (int i = 0; i < 4; ++i) { o0[i] = (a0[i] * co[i] - a1[i] * si[i]) * sc; o1[i] = (a1[i] * co[i] + a0[i] * si[i]) * sc; }
                    } else { o0 = a0; o1 = a1; }
                    f16* p = dst + (size_t)row * pitch + col + d0;
                    *(f16x4*)p = cvt4(o0); *(f16x4*)(p + 32) = cvt4(o1);
                }
            }
    }
};
struct EpiResid {
    static constexpr bool PERM = false, AFTER_DRAIN = false;
    const float* xin; float* out; const float* gate;
    __device__ __forceinline__ void operator()(const f32x4 (&acc)[2][2][4][2], const pg8::Unit& u, int wr, int wc, int fr, int fq) const {
        const int b = (u.pm * 256) / SEQ;
        f32x4 gt[2][2];
#pragma unroll
        for (int bj = 0; bj < 2; ++bj)
#pragma unroll
            for (int n = 0; n < 2; ++n) { gt[bj][n] = *(const f32x4*)(gate + (size_t)b * 6 * DM + u.pn * 256 + bj * 128 + wc * 32 + n * 16 + 4 * fq); gt[bj][n] = gt[bj][n] + 1.0f; }
#pragma unroll
        for (int ai = 0; ai < 2; ++ai)
#pragma unroll
            for (int m = 0; m < 4; ++m) {
                const int row = u.pm * 256 + ai * 128 + wr * 64 + m * 16 + fr;
#pragma unroll
                for (int bj = 0; bj < 2; ++bj)
#pragma unroll
                    for (int n = 0; n < 2; ++n) {
                        const size_t off = (size_t)row * DM + u.pn * 256 + bj * 128 + wc * 32 + n * 16 + 4 * fq;
                        const f32x4 xv = *(const f32x4*)(xin + off);
                        *(f32x4*)(out + off) = xv * ALPHA + gt[bj][n] * acc[ai][bj][m][n];
                    }
            }
    }
};
struct EpiSwiglu {
    static constexpr bool PERM = false, AFTER_DRAIN = false;
    f16* act;
    __device__ __forceinline__ void operator()(const f32x4 (&acc)[2][2][4][2], const pg8::Unit& u, int wr, int wc, int fr, int fq) const {
#pragma unroll
        for (int ai = 0; ai < 2; ++ai)
#pragma unroll
            for (int m = 0; m < 4; ++m) {
                const int row = u.pm * 256 + ai * 128 + wr * 64 + m * 16 + fr;
#pragma unroll
                for (int bj = 0; bj < 2; ++bj) {
                    const int f0 = (u.pn * 256 + bj * 128 + wc * 32) / 2 + 4 * fq;
                    const f32x4 g = acc[ai][bj][m][0], up = acc[ai][bj][m][1]; f32x4 o;
#pragma unroll
                    for (int i = 0; i < 4; ++i) { const float e = __builtin_amdgcn_exp2f(-g[i] * LOG2E); o[i] = g[i] * __builtin_amdgcn_rcpf(1.0f + e) * up[i]; }
                    *(f16x4*)(act + (size_t)row * DFF + f0) = cvt4(o);
                }
            }
    }
};

struct Params {
    const float* x; const float* c; const int* pos; const float* w_ada; const float* b_ada; const float* w_in; const float* sinks; const float* g_a; const float* g_b; const float* w_o;
    const float* ln1_g; const float* ln1_b; const float* w_gate; const float* w_up; const float* w_down; const float* ln2_g; const float* ln2_b;
    float* out; unsigned char* ws;
    int ph_lo, ph_hi, use_cg, pad;
};
constexpr int NPHASE = 2 + 8 * DEPTH;
constexpr int LDS_BYTES = 147456;

__device__ __forceinline__ int wave_sum_i(int v) {
#pragma unroll
    for (int o = 1; o < 64; o <<= 1) v += __shfl_xor(v, o);
    return v;
}
__device__ __forceinline__ float wave_sum(float v) {
#pragma unroll
    for (int o = 1; o < 64; o <<= 1) v += __shfl_xor(v, o);
    return v;
}

template <class Map>
__device__ __forceinline__ void transpose_items(const Map& map, int K, int nphys, f16* WT, LAS float* scr, int gw, int NGW, int lane) {
    const int nkb = K / 64, nitems = (nphys / 32) * nkb;
    for (int it = gw; it < nitems; it += NGW) {
        const int pg = it / nkb, kb = it % nkb, k0 = kb * 64;
        const float* src = map.src(pg * 32 + (lane & 31)); const size_t ld = (size_t)Map::LD;
#pragma unroll 8
        for (int i = 0; i < 32; ++i) { const int kk = 2 * i + (lane >> 5); const float v = src ? src[(size_t)(k0 + kk) * ld] : 0.f; scr[kk * 33 + (lane & 31)] = v; }
        asm volatile("s_waitcnt lgkmcnt(0)" ::: "memory");
        const int c = lane & 7;
#pragma unroll
        for (int j = 0; j < 4; ++j) { const int n = (lane >> 3) + 8 * j; const LAS float* s = scr + (8 * c) * 33 + n;
            f16x8 o;
#pragma unroll
            for (int e = 0; e < 8; ++e) o[e] = (f16)s[e * 33];
            *(f16x8*)(WT + (size_t)(pg * 32 + n) * K + k0 + 8 * c) = o; }
        asm volatile("s_waitcnt lgkmcnt(0)" ::: "memory");
    }
}
struct MapIn { const float* w; static constexpr int LD = NIN;
    __device__ __forceinline__ const float* src(int p) const {
        if (p < 2112) { const int hb = p >> 6, within = p & 63, grp = within >> 5, half = (within & 31) >> 4, off = within & 15; return w + hb * 64 + 16 * grp + off + 32 * half; }
        return (p < NIN) ? (w + p) : nullptr; } };
struct MapGU { const float* wg; const float* wu; static constexpr int LD = DFF;
    __device__ __forceinline__ const float* src(int p) const { const int blk = p >> 5, within = p & 31, which = within >> 4, off = within & 15; const long long dlt = (const char*)wu - (const char*)wg; return (const float*)((const char*)wg + (long long)which * dlt) + 16 * blk + off; } };
struct MapD { const float* w; static constexpr int LD = DM;
    __device__ __forceinline__ const float* src(int p) const { return w + p; } };

__device__ __forceinline__ void sincos_acc(float ang, float& c, float& s) {
    const double x = (double)ang;
    const double n = rint(x * 0.63661977236758134308);
    const double r = fma(-n, 1.57079632679489661923, x) - n * 6.123233995736766e-17;
    const double r2 = r * r;
    double sp = -7.6471637318198164759e-13; sp = fma(sp, r2, 1.6059043836821614599e-10); sp = fma(sp, r2, -2.5052108385441718775e-8); sp = fma(sp, r2, 2.7557319223985890653e-6);
    sp = fma(sp, r2, -1.9841269841269841270e-4); sp = fma(sp, r2, 8.3333333333333333333e-3); sp = fma(sp, r2, -1.6666666666666666667e-1); sp = fma(sp * r2, r, r);
    double cp = 4.7794773323873852974e-14; cp = fma(cp, r2, -1.1470745597729724714e-11); cp = fma(cp, r2, 2.0876756987868098979e-9); cp = fma(cp, r2, -2.7557319223985890653e-7);
    cp = fma(cp, r2, 2.4801587301587301587e-5); cp = fma(cp, r2, -1.3888888888888888889e-3); cp = fma(cp, r2, 4.1666666666666666667e-2); cp = fma(cp, r2, -0.5); cp = fma(cp, r2, 1.0);
    const int q = ((int)n) & 3;
    const double sv = (q & 1) ? cp : sp, cv = (q & 1) ? sp : cp;
    s = (float)((q & 2) ? -sv : sv); c = (float)(((q + 1) & 2) ? -cv : cv);
}

__device__ __forceinline__ void phase_prep(const Params& P, LAS unsigned char* lds, const int wave_s) {
    const int tid = TIDX(wave_s), lane = tid & 63, wave = wave_s, G = gridDim.x;
    {
        LAS float* cact = (LAS float*)lds;
        LAS float* red = (LAS float*)(lds + 32768);
        for (int i = tid; i < BATCH * DM; i += 512) { const float v = P.c[i]; cact[i] = v / (1.0f + __expf(-v)); }
        __syncthreads();
        const int nitems = DEPTH * (6 * DM / 32);
        for (int it = blockIdx.x; it < nitems; it += G) {
            const int l = it / (6 * DM / 32), n0 = (it % (6 * DM / 32)) * 32, col = lane & 31, slice = wave * 2 + (lane >> 5);
            const float* w = P.w_ada + (size_t)l * DM * 6 * DM + n0 + col;
            float a[8] = {0.f, 0.f, 0.f, 0.f, 0.f, 0.f, 0.f, 0.f};
#pragma unroll 8
            for (int kk = 0; kk < 64; ++kk) { const int k = slice * 64 + kk; const float wv = w[(size_t)k * 6 * DM];
#pragma unroll
                for (int b = 0; b < 8; ++b) a[b] += cact[b * DM + k] * wv; }
#pragma unroll
            for (int b = 0; b < 8; ++b) red[(slice * 8 + b) * 32 + col] = a[b];
            __syncthreads();
            if (tid < 256) { const int b = tid >> 5, cc = tid & 31; float s = P.b_ada[(size_t)l * 6 * DM + n0 + cc];
#pragma unroll
                for (int sl = 0; sl < 16; ++sl) s += red[(sl * 8 + b) * 32 + cc];
                ((float*)(P.ws + WS_MOD))[((size_t)l * BATCH + b) * 6 * DM + n0 + cc] = s; }
            __syncthreads();
        }
    }
    {
        float* cs = (float*)(P.ws + WS_ROPE);
        for (int i = blockIdx.x * 512 + tid; i < MTOK * 32; i += G * 512) { const int tok = i >> 5, j = i & 31;
            const float ang = (float)P.pos[tok] * (float)exp2((double)j * (-13.287712379549449 / 32.0)); float c, s; sincos_acc(ang, c, s); cs[2 * (size_t)i] = c; cs[2 * (size_t)i + 1] = s; }
    }
    {
        __syncthreads();
        LAS float* scr = (LAS float*)(lds + wave * 16384);
        const int gw = blockIdx.x * 8 + wave, NGW = G * 8;
        for (int l = 0; l < DEPTH; ++l) {
            unsigned char* wb = P.ws + WS_W + l * W_LAYER;
            transpose_items(MapIn{P.w_in + (size_t)l * DM * NIN}, DM, NINP, (f16*)(wb + W_IN), scr, gw, NGW, lane);
            {
                const float* wo = P.w_o + (size_t)l * DM * DM; const float* ga = P.g_a + l * 512; const float* gb = P.g_b + l * 512;
                const int nkb = DM / 64, nitems = (DM / 32) * nkb;
                for (int it = gw; it < nitems; it += NGW) {
                    const int pg = it / nkb, kb = it % nkb, k0 = kb * 64; const float* ksc = (k0 < 512) ? (ga + k0) : (gb + (k0 - 512));
                    const float* src = wo + pg * 32 + (lane & 31);
#pragma unroll 8
                    for (int i = 0; i < 32; ++i) { const int kk = 2 * i + (lane >> 5); scr[kk * 33 + (lane & 31)] = src[(size_t)(k0 + kk) * DM] * ksc[kk]; }
                    asm volatile("s_waitcnt lgkmcnt(0)" ::: "memory");
                    const int c = lane & 7;
#pragma unroll
                    for (int j = 0; j < 4; ++j) { const int n = (lane >> 3) + 8 * j; const LAS float* s = scr + (8 * c) * 33 + n; f16x8 o;
#pragma unroll
                        for (int e = 0; e < 8; ++e) o[e] = (f16)s[e * 33];
                        *(f16x8*)((f16*)(wb + W_O) + (size_t)(pg * 32 + n) * DM + k0 + 8 * c) = o; }
                    asm volatile("s_waitcnt lgkmcnt(0)" ::: "memory");
                }
            }
            transpose_items(MapGU{P.w_gate + (size_t)l * DM * DFF, P.w_up + (size_t)l * DM * DFF}, DM, NGU, (f16*)(wb + W_GU), scr, gw, NGW, lane);
            transpose_items(MapD{P.w_down + (size_t)l * DFF * DM}, DFF, DM, (f16*)(wb + W_D), scr, gw, NGW, lane);
        }
    }
}

__device__ __forceinline__ void phase_h0(const Params& P, const int wave_s) {
    const float* mod = (const float*)(P.ws + WS_MOD); f16* H = (f16*)(P.ws + WS_H);
    const size_t n8 = (size_t)MTOK * DM / 8;
    for (size_t i = (size_t)blockIdx.x * 512 + TIDX(wave_s); i < n8; i += (size_t)gridDim.x * 512) {
        const size_t e = i * 8; const int row = (int)(e / DM), col = (int)(e % DM), b = row / SEQ;
        const f32x4 x0 = *(const f32x4*)(P.x + e), x1 = *(const f32x4*)(P.x + e + 4);
        const float* mb = mod + (size_t)b * 6 * DM;
        const f32x4 sh0 = *(const f32x4*)(mb + col), sh1 = *(const f32x4*)(mb + col + 4), sc0 = *(const f32x4*)(mb + DM + col), sc1 = *(const f32x4*)(mb + DM + col + 4);
        const f32x4 h0 = x0 * (sc0 + 1.0f) + sh0, h1 = x1 * (sc1 + 1.0f) + sh1;
        f16x8 o = {(f16)h0[0], (f16)h0[1], (f16)h0[2], (f16)h0[3], (f16)h1[0], (f16)h1[1], (f16)h1[2], (f16)h1[3]};
        *(f16x8*)(H + e) = o;
    }
}

__device__ __forceinline__ float dot64(const u32x4 (&q)[8], const u32x4 (&k)[8]) {
    float s = 0.f;
#pragma unroll
    for (int i = 0; i < 8; ++i)
#pragma unroll
        for (int j = 0; j < 4; ++j) { const unsigned qa_ = q[i][j], kb_ = k[i][j]; s = __builtin_amdgcn_fdot2(__builtin_bit_cast(f16x2, qa_), __builtin_bit_cast(f16x2, kb_), s, false); }
    return s;
}
__device__ __forceinline__ void phase_swa_naive(const Params& P, int l, const int wave_s) {
    const unsigned char* qkv = P.ws + WS_QKV;
    const f16* QA = (const f16*)(qkv + O_QA); const f16* KA = (const f16*)(qkv + O_KA); const f16* VA = (const f16*)(qkv + O_VA); f16* Y = (f16*)(qkv + O_Y);
    for (int idx = blockIdx.x * 512 + TIDX(wave_s); idx < MTOK * 8; idx += gridDim.x * 512) {
        const int tok = idx >> 3, h = idx & 7, kvh = h >> 2, t = tok % SEQ, b = tok / SEQ;
        u32x4 q[8];
#pragma unroll
        for (int i = 0; i < 8; ++i) q[i] = *(const u32x4*)(QA + (size_t)tok * 512 + h * 64 + i * 8);
        float m = P.sinks[l * 8 + h] * LOG2E, lsum = 1.0f;
        float o[64];
#pragma unroll
        for (int d = 0; d < 64; ++d) o[d] = 0.f;
        const int s0 = t - 127 < 0 ? 0 : t - 127;
        for (int s = s0; s <= t; ++s) {
            const size_t kr = ((size_t)(b * SEQ + s)) * 128 + kvh * 64;
            u32x4 k[8];
#pragma unroll
            for (int i = 0; i < 8; ++i) k[i] = *(const u32x4*)(KA + kr + i * 8);
            const float sc = dot64(q, k);
            const float mn = fmaxf(m, sc), al = __builtin_amdgcn_exp2f(m - mn), p = __builtin_amdgcn_exp2f(sc - mn);
            lsum = lsum * al + p; m = mn;
#pragma unroll
            for (int i = 0; i < 8; ++i) { const f16x8 v = *(const f16x8*)(VA + kr + i * 8);
#pragma unroll
                for (int e = 0; e < 8; ++e) o[i * 8 + e] = o[i * 8 + e] * al + p * (float)v[e]; }
        }
        const float il = 1.0f / lsum; float ss = 0.f;
#pragma unroll
        for (int d = 0; d < 64; ++d) { o[d] *= il; ss += o[d] * o[d]; }
        ss += __shfl_xor(ss, 1); ss += __shfl_xor(ss, 2); ss += __shfl_xor(ss, 4);
        const float r = 1.0f / sqrtf(ss * (1.0f / 512.0f) + 1e-6f);
#pragma unroll
        for (int i = 0; i < 8; ++i) { f16x8 w;
#pragma unroll
            for (int e = 0; e < 8; ++e) w[e] = (f16)(o[i * 8 + e] * r);
            *(f16x8*)(Y + (size_t)tok * DM + h * 64 + i * 8) = w; }
    }
}
__device__ __forceinline__ void phase_select_naive(const Params& P, LAS unsigned char* lds, const int wave_s) {
    const unsigned char* qkv = P.ws + WS_QKV;
    const f16* QI = (const f16*)(qkv + O_QI); const f16* KI = (const f16*)(qkv + O_KI); const float* WI = (const float*)(qkv + O_WI);
    unsigned long long* MASK = (unsigned long long*)(P.ws + WS_MASK);
    const int tid = TIDX(wave_s), lane = tid & 63, wave = wave_s;
    LAS unsigned* qs = (LAS unsigned*)(lds + wave * 9216);
    LAS float* ssc = (LAS float*)(lds + wave * 9216 + 1024);
    for (int tok = blockIdx.x * 8 + wave; tok < MTOK; tok += gridDim.x * 8) {
        const int t = tok % SEQ, b = tok / SEQ;
        unsigned long long* mrow = MASK + (size_t)tok * 32;
        if (t < TOPK) {
            if (lane < 32) { const int lo = lane * 64; unsigned long long w = 0ull;
                if (lo + 63 <= t) w = ~0ull; else if (lo <= t) w = (1ull << (t - lo + 1)) - 1ull;
                mrow[lane] = w; }
            continue;
        }
        { const u32x4 v = *(const u32x4*)(QI + (size_t)tok * 512 + lane * 8); *(LAS u32x4*)(qs + lane * 4) = v; }
        float wv[8];
#pragma unroll
        for (int h = 0; h < 8; ++h) wv[h] = WI[(size_t)tok * 8 + h];
        asm volatile("s_waitcnt lgkmcnt(0)" ::: "memory");
        const int nch = t / 64 + 1;
        for (int c = 0; c < nch; ++c) {
            const int s = c * 64 + lane;
            u32x4 k[8];
#pragma unroll
            for (int i = 0; i < 8; ++i) k[i] = *(const u32x4*)(KI + ((size_t)(b * SEQ + s)) * 64 + i * 8);
            float sc = 0.f;
#pragma unroll
            for (int h = 0; h < 8; ++h) { float d = 0.f;
#pragma unroll
                for (int i = 0; i < 8; ++i) { const u32x4 qv = *(const LAS u32x4*)(qs + h * 32 + i * 4);
#pragma unroll
                    for (int j = 0; j < 4; ++j) { const unsigned qa_ = qv[j], kb_ = k[i][j]; d = __builtin_amdgcn_fdot2(__builtin_bit_cast(f16x2, qa_), __builtin_bit_cast(f16x2, kb_), d, false); } }
                sc += wv[h] * fmaxf(d, 0.f); }
            ssc[s] = sc;
        }
        asm volatile("s_waitcnt lgkmcnt(0)" ::: "memory");
        unsigned u[32];
#pragma unroll
        for (int i = 0; i < 32; ++i) { const int s = i * 64 + lane; unsigned v = 0u;
            if (s <= t) { const unsigned bits = __float_as_uint(ssc[s] + 0.0f); v = (bits & 0x80000000u) ? ~bits : (bits | 0x80000000u); }
            u[i] = v; }
        unsigned T = 0u;
        for (int bit = 31; bit >= 0; --bit) {
            const unsigned cand = T | (1u << bit); int cnt = 0;
#pragma unroll
            for (int i = 0; i < 32; ++i) cnt += (u[i] >= cand) ? 1 : 0;
            cnt = wave_sum_i(cnt);
            if (cnt >= TOPK) T = cand;
        }
        int cgt = 0;
#pragma unroll
        for (int i = 0; i < 32; ++i) cgt += (u[i] > T) ? 1 : 0;
        cgt = wave_sum_i(cgt);
        const int need = TOPK - cgt; int run = 0;
        const unsigned long long lt = (lane == 0) ? 0ull : ((~0ull) >> (64 - lane));
#pragma unroll
        for (int i = 0; i < 32; ++i) {
            const bool gt = u[i] > T, eq = u[i] == T;
            const unsigned long long eqb = __ballot(eq);
            const int pre = run + __popcll(eqb & lt);
            const unsigned long long w = __ballot(gt || (eq && pre < need));
            run += __popcll(eqb);
            if (lane == 0) mrow[i] = w;
        }
    }
}
__device__ __forceinline__ void phase_dsa_naive(const Params& P, const int wave_s) {
    const unsigned char* qkv = P.ws + WS_QKV;
    const f16* QB = (const f16*)(qkv + O_QB); const f16* KB = (const f16*)(qkv + O_KB); const f16* VB = (const f16*)(qkv + O_VB); f16* Y = (f16*)(qkv + O_Y);
    const unsigned long long* MASK = (const unsigned long long*)(P.ws + WS_MASK);
    for (int idx = blockIdx.x * 512 + TIDX(wave_s); idx < MTOK * 8; idx += gridDim.x * 512) {
        const int tok = idx >> 3, h = idx & 7, kvh = h >> 2, t = tok % SEQ, b = tok / SEQ;
        u32x4 q[8];
#pragma unroll
        for (int i = 0; i < 8; ++i) q[i] = *(const u32x4*)(QB + (size_t)tok * 512 + h * 64 + i * 8);
        float m = -1e30f, lsum = 0.f;
        float o[64];
#pragma unroll
        for (int d = 0; d < 64; ++d) o[d] = 0.f;
        const int nw = t / 64 + 1;
        for (int wi_ = 0; wi_ < nw; ++wi_) {
            unsigned long long bits = MASK[(size_t)tok * 32 + wi_];
            while (bits) {
                const int j = __builtin_ctzll(bits); bits &= bits - 1ull;
                const int s = wi_ * 64 + j;
                const size_t kr = ((size_t)(b * SEQ + s)) * 128 + kvh * 64;
                u32x4 k[8];
#pragma unroll
                for (int i = 0; i < 8; ++i) k[i] = *(const u32x4*)(KB + kr + i * 8);
                const float sc = dot64(q, k);
                const float mn = fmaxf(m, sc), al = __builtin_amdgcn_exp2f(m - mn), p = __builtin_amdgcn_exp2f(sc - mn);
                lsum = lsum * al + p; m = mn;
#pragma unroll
                for (int i = 0; i < 8; ++i) { const f16x8 v = *(const f16x8*)(VB + kr + i * 8);
#pragma unroll
                    for (int e = 0; e < 8; ++e) o[i * 8 + e] = o[i * 8 + e] * al + p * (float)v[e]; }
            }
        }
        const float il = 1.0f / lsum; float ss = 0.f;
#pragma unroll
        for (int d = 0; d < 64; ++d) { o[d] *= il; ss += o[d] * o[d]; }
        ss += __shfl_xor(ss, 1); ss += __shfl_xor(ss, 2); ss += __shfl_xor(ss, 4);
        const float r = 1.0f / sqrtf(ss * (1.0f / 512.0f) + 1e-6f);
#pragma unroll
        for (int i = 0; i < 8; ++i) { f16x8 w;
#pragma unroll
            for (int e = 0; e < 8; ++e) w[e] = (f16)(o[i * 8 + e] * r);
            *(f16x8*)(Y + (size_t)tok * DM + 512 + h * 64 + i * 8) = w; }
    }
}

__device__ __forceinline__ void phase_ln(const Params& P, const float* g, const float* bta, const float* mod_next  , const int wave_s) {
    const int lane = TIDX(wave_s) & 63, wave = wave_s; f16* H = (f16*)(P.ws + WS_H);
    for (int row = blockIdx.x * 8 + wave; row < MTOK; row += gridDim.x * 8) {
        float* xr = P.out + (size_t)row * DM; const int b = row / SEQ;
        f32x4 v[4]; float s = 0.f;
#pragma unroll
        for (int j = 0; j < 4; ++j) { v[j] = *(const f32x4*)(xr + j * 256 + lane * 4); s += (v[j][0] + v[j][1]) + (v[j][2] + v[j][3]); }
        const float mean = wave_sum(s) * (1.0f / DM); float s2 = 0.f;
#pragma unroll
        for (int j = 0; j < 4; ++j) { v[j] = v[j] - mean; s2 += (v[j][0] * v[j][0] + v[j][1] * v[j][1]) + (v[j][2] * v[j][2] + v[j][3] * v[j][3]); }
        const float rstd = 1.0f / sqrtf(wave_sum(s2) * (1.0f / DM) + 1e-5f);
#pragma unroll
        for (int j = 0; j < 4; ++j) { const int col = j * 256 + lane * 4;
            const f32x4 gg = *(const f32x4*)(g + col), bb = *(const f32x4*)(bta + col);
            const f32x4 xo = v[j] * rstd * gg + bb;
            *(f32x4*)(xr + col) = xo;
            if (mod_next) { const f32x4 sh = *(const f32x4*)(mod_next + (size_t)b * 6 * DM + col), sc = *(const f32x4*)(mod_next + (size_t)b * 6 * DM + DM + col);
                *(f16x4*)(H + (size_t)row * DM + col) = cvt4(xo * (sc + 1.0f) + sh); } }
    }
}

template <int L, int SUB>
__device__ __forceinline__ void layer_phase(const Params& P, LAS unsigned char* lds, const int wave_s) {
    const int G = gridDim.x;
    unsigned char* ws = P.ws; unsigned char* qkv = ws + WS_QKV;
    unsigned char* wb = ws + WS_W + (size_t)L * W_LAYER;
    const float* modl = (const float*)(ws + WS_MOD) + (size_t)L * BATCH * 6 * DM;
    if constexpr (SUB == 0) {
        pg8::Gemm g{(const h16_t*)(ws + WS_H), (const h16_t*)(wb + W_IN), MTOK, NINP, DM}; pg8::StaticOrder S; S.init(MTOK, NINP, G, (int)blockIdx.x);
        EpiRope E{(f16*)(qkv + O_QA), (f16*)(qkv + O_KA), (f16*)(qkv + O_VA), (f16*)(qkv + O_QB), (f16*)(qkv + O_KB), (f16*)(qkv + O_VB), (f16*)(qkv + O_QI), (f16*)(qkv + O_KI), (float*)(qkv + O_WI), (const float*)(ws + WS_ROPE)};
        pg8::gemm_phase<EpiRope, pg8::StaticOrder, true, true>(lds, g, S, E, wave_s);
    } else if constexpr (SUB == 1) { phase_swa_naive(P, L, wave_s); phase_select_naive(P, lds, wave_s); }
    else if constexpr (SUB == 2) phase_dsa_naive(P, wave_s);
    else if constexpr (SUB == 3) {
        pg8::Gemm g{(const h16_t*)(qkv + O_Y), (const h16_t*)(wb + W_O), MTOK, DM, DM}; pg8::StaticOrder S; S.init(MTOK, DM, G, (int)blockIdx.x);
        EpiResid E{L == 0 ? P.x : P.out, P.out, modl + 2 * DM};
        pg8::gemm_phase<EpiResid, pg8::StaticOrder, true, true>(lds, g, S, E, wave_s);
    } else if constexpr (SUB == 4) phase_ln(P, P.ln1_g + L * DM, P.ln1_b + L * DM, modl + 3 * DM, wave_s);
    else if constexpr (SUB == 5) {
        pg8::Gemm g{(const h16_t*)(ws + WS_H), (const h16_t*)(wb + W_GU), MTOK, NGU, DM}; pg8::StaticOrder S; S.init(MTOK, NGU, G, (int)blockIdx.x);
        EpiSwiglu E{(f16*)qkv};
        pg8::gemm_phase<EpiSwiglu, pg8::StaticOrder, true, true>(lds, g, S, E, wave_s);
    } else if constexpr (SUB == 6) {
        pg8::Gemm g{(const h16_t*)qkv, (const h16_t*)(wb + W_D), MTOK, DM, DFF}; pg8::StaticOrder S; S.init(MTOK, DM, G, (int)blockIdx.x);
        EpiResid E{P.out, P.out, modl + 5 * DM};
        pg8::gemm_phase<EpiResid, pg8::StaticOrder, true, true>(lds, g, S, E, wave_s);
    } else phase_ln(P, P.ln2_g + L * DM, P.ln2_b + L * DM, (L + 1 < DEPTH) ? (modl + BATCH * 6 * DM) : nullptr, wave_s);
}

__global__ void __launch_bounds__(512, 2) mk_fwd(Params P) {
    extern __shared__ __attribute__((aligned(16))) unsigned char lds_raw[];
    LAS unsigned char* lds = (LAS unsigned char*)lds_raw;
    const int lo = P.ph_lo, hi = P.ph_hi, use_cg = P.use_cg;
    const int wave_s = __builtin_amdgcn_readfirstlane(threadIdx.x >> 6);
    typedef const __attribute__((address_space(4))) Params* CParams;
#if defined(__HIP_DEVICE_COMPILE__)
#define FRESH() CParams pp_ = (CParams)__builtin_amdgcn_kernarg_segment_ptr(); asm volatile("" : "+s"(pp_)); const Params Pl = *pp_;
#else
#define FRESH() const Params Pl = P;
#endif
#define IN(k) (lo <= (k) && (k) < hi)
#define SEAM(k) do { if (IN((k) + 1)) { if (use_cg) cg::this_grid().sync(); } __syncthreads(); } while (0)
#define LPH(L, SUB) if (IN(2 + 8 * (L) + (SUB))) { { FRESH(); layer_phase<L, SUB>(Pl, lds, wave_s); } SEAM(2 + 8 * (L) + (SUB)); }
    if (IN(0)) { { FRESH(); phase_prep(Pl, lds, wave_s); } SEAM(0); }
    if (IN(1)) { { FRESH(); phase_h0(Pl, wave_s); } SEAM(1); }
    LPH(0, 0) LPH(0, 1) LPH(0, 2) LPH(0, 3) LPH(0, 4) LPH(0, 5) LPH(0, 6) LPH(0, 7)
    LPH(1, 0) LPH(1, 1) LPH(1, 2) LPH(1, 3) LPH(1, 4) LPH(1, 5) LPH(1, 6) LPH(1, 7)
#undef IN
#undef SEAM
#undef LPH
}

#ifndef MK_CHECK
#define MK_CHECK 0
#define MK_CHECK_LAYER 0
#define MK_CHECK_BASE 0
#endif
#if MK_CHECK
__device__ __forceinline__ void flag_max(float* f, float err) { if (!(err == err)) err = 1e30f; atomicMax((int*)f, __float_as_int(err)); }
__device__ __forceinline__ int samp_tok(int j) { return (int)(((long)j * 5231 + 1777) % MTOK); }
__global__ void chk_mod(Params P, float* flags) {
    const int j = blockIdx.x * blockDim.x + threadIdx.x; if (j >= 512) return;
    const int l = j & 1, b = (j >> 1) & 7, n = ((j >> 4) * 197 + 13) % (6 * DM);
    float ref = P.b_ada[l * 6 * DM + n];
    for (int k = 0; k < DM; ++k) { const float v = P.c[b * DM + k]; ref += (v / (1.0f + expf(-v))) * P.w_ada[((size_t)l * DM + k) * 6 * DM + n]; }
    const float got = ((const float*)(P.ws + WS_MOD))[((size_t)l * BATCH + b) * 6 * DM + n];
    flag_max(flags + 0, fabsf(ref - got) / (fabsf(ref) + 0.02f));
}
__global__ void chk_inproj(Params P, float* flags, int L) {
    const int j = blockIdx.x * blockDim.x + threadIdx.x; if (j >= 32 * 34 * 2) return;
    const int tok = samp_tok(j / 68), r = j % 68, hb = r >> 1, dd = (r & 1) ? 21 : 3, b = tok / SEQ;
    const float* mod = (const float*)(P.ws + WS_MOD) + ((size_t)L * BATCH + b) * 6 * DM;
    const float* w = P.w_in + (size_t)L * DM * NIN;
    const float* xr = (L == 0 ? P.x : P.out) + (size_t)tok * DM;
    const unsigned char* qkv = P.ws + WS_QKV;
    if (hb == 33) {
        const int c = 2112 + (dd == 3 ? 1 : 6); float a = 0.f;
        for (int k = 0; k < DM; ++k) { const float h = (float)(f16)(xr[k] * (1.0f + mod[DM + k]) + mod[k]); a += h * (float)(f16)w[(size_t)k * NIN + c]; }
        const float got = ((const float*)(qkv + O_WI))[(size_t)tok * 8 + (c - 2112)];
        flag_max(flags + 1, fabsf(a - got) / (fabsf(a) + 0.05f)); return;
    }
    const int c = hb * 64 + dd; float a1 = 0.f, a2 = 0.f;
    for (int k = 0; k < DM; ++k) { const float h = (float)(f16)(xr[k] * (1.0f + mod[DM + k]) + mod[k]); a1 += h * (float)(f16)w[(size_t)k * NIN + c]; a2 += h * (float)(f16)w[(size_t)k * NIN + c + 32]; }
    const f16* dst; int pitch, col; bool rope = true; float sc = 1.f;
    if (hb < 8) { dst = (const f16*)(qkv + O_QA); pitch = 512; col = hb * 64; sc = QSCALE; }
    else if (hb < 10) { dst = (const f16*)(qkv + O_KA); pitch = 128; col = (hb - 8) * 64; }
    else if (hb < 12) { dst = (const f16*)(qkv + O_VA); pitch = 128; col = (hb - 10) * 64; rope = false; }
    else if (hb < 20) { dst = (const f16*)(qkv + O_QB); pitch = 512; col = (hb - 12) * 64; sc = QSCALE; }
    else if (hb < 22) { dst = (const f16*)(qkv + O_KB); pitch = 128; col = (hb - 20) * 64; }
    else if (hb < 24) { dst = (const f16*)(qkv + O_VB); pitch = 128; col = (hb - 22) * 64; rope = false; }
    else if (hb < 32) { dst = (const f16*)(qkv + O_QI); pitch = 512; col = (hb - 24) * 64; }
    else { dst = (const f16*)(qkv + O_KI); pitch = 64; col = 0; }
    float o1 = a1, o2 = a2;
    if (rope) { const float inv = powf(10000.0f, -(float)dd / 32.0f); const float ang = (float)P.pos[tok] * inv; const float cs = (float)cos((double)ang), sn = (float)sin((double)ang);
        o1 = (a1 * cs - a2 * sn) * sc; o2 = (a2 * cs + a1 * sn) * sc; }
    const float g1 = (float)dst[(size_t)tok * pitch + col + dd], g2 = (float)dst[(size_t)tok * pitch + col + dd + 32];
    flag_max(flags + 1, fabsf(o1 - g1) / (fabsf(o1) + 0.05f)); flag_max(flags + 1, fabsf(o2 - g2) / (fabsf(o2) + 0.05f));
}
__global__ void chk_swa(Params P, float* flags, int L) {
    __shared__ float sc[8][128]; __shared__ float red[512]; __shared__ float den[8];
    const int tok = samp_tok(blockIdx.x * 7 + 3), t = tok % SEQ, b = tok / SEQ, tid = threadIdx.x, h = tid >> 6, d = tid & 63, kvh = h >> 2;
    const unsigned char* qkv = P.ws + WS_QKV;
    const f16* QA = (const f16*)(qkv + O_QA); const f16* KA = (const f16*)(qkv + O_KA); const f16* VA = (const f16*)(qkv + O_VA); const f16* Y = (const f16*)(qkv + O_Y);
    const int s0 = t - 127 < 0 ? 0 : t - 127, nk = t - s0 + 1;
    for (int i = d; i < nk; i += 64) { float a = 0.f; for (int e = 0; e < 64; ++e) a += (float)QA[(size_t)tok * 512 + h * 64 + e] * (float)KA[((size_t)(b * SEQ + s0 + i)) * 128 + kvh * 64 + e]; sc[h][i] = a; }
    __syncthreads();
    if (d == 0) { float m = P.sinks[L * 8 + h] * LOG2E; for (int i = 0; i < nk; ++i) m = fmaxf(m, sc[h][i]); float dn = exp2f(P.sinks[L * 8 + h] * LOG2E - m); for (int i = 0; i < nk; ++i) { const float p = exp2f(sc[h][i] - m); sc[h][i] = p; dn += p; } den[h] = dn; }
    __syncthreads();
    float o = 0.f; for (int i = 0; i < nk; ++i) o += sc[h][i] * (float)VA[((size_t)(b * SEQ + s0 + i)) * 128 + kvh * 64 + d];
    o /= den[h]; red[tid] = o * o; __syncthreads();
    for (int st = 256; st > 0; st >>= 1) { if (tid < st) red[tid] += red[tid + st]; __syncthreads(); }
    const float ref = o / sqrtf(red[0] / 512.0f + 1e-6f), got = (float)Y[(size_t)tok * DM + h * 64 + d];
    flag_max(flags + 2, fabsf(ref - got) / (fabsf(ref) + 0.1f));
}
__global__ void chk_dsa(Params P, float* flags) {
    __shared__ float ssc[2048]; __shared__ unsigned char sel[2048]; __shared__ float red[512]; __shared__ float pm[8], dn[8]; __shared__ float diff[512];
    const int tok = samp_tok(blockIdx.x * 61 + 5), t = tok % SEQ, b = tok / SEQ, tid = threadIdx.x, h = tid >> 6, d = tid & 63, kvh = h >> 2;
    const unsigned char* qkv = P.ws + WS_QKV;
    const f16* QB = (const f16*)(qkv + O_QB); const f16* KB = (const f16*)(qkv + O_KB); const f16* VB = (const f16*)(qkv + O_VB); const f16* Y = (const f16*)(qkv + O_Y);
    const f16* QI = (const f16*)(qkv + O_QI); const f16* KI = (const f16*)(qkv + O_KI); const float* WI = (const float*)(qkv + O_WI);
    for (int s = tid; s <= t; s += 512) { float tot = 0.f;
        for (int hh = 0; hh < 8; ++hh) { float a = 0.f; for (int e = 0; e < 64; ++e) a += (float)QI[(size_t)tok * 512 + hh * 64 + e] * (float)KI[((size_t)(b * SEQ + s)) * 64 + e]; tot += WI[(size_t)tok * 8 + hh] * fmaxf(a, 0.f); }
        ssc[s] = tot + 0.0f; }
    __syncthreads();
    for (int s = tid; s <= t; s += 512) { int rank = 0; const float v = ssc[s]; for (int i = 0; i <= t; ++i) { const float w = ssc[i]; rank += (w > v || (w == v && i < s)) ? 1 : 0; } sel[s] = rank < TOPK ? 1 : 0; }
    __syncthreads();
    float o = 0.f;
    for (int hh = 0; hh < 8; ++hh) {
        __syncthreads();
        for (int s = tid; s <= t; s += 512) { float a = -INFINITY; if (sel[s]) { a = 0.f; for (int e = 0; e < 64; ++e) a += (float)QB[(size_t)tok * 512 + hh * 64 + e] * (float)KB[((size_t)(b * SEQ + s)) * 128 + (hh >> 2) * 64 + e]; } ssc[s] = a; }
        __syncthreads();
        if (tid == 0) { float m = -INFINITY; for (int s = 0; s <= t; ++s) m = fmaxf(m, ssc[s]); float dd = 0.f; for (int s = 0; s <= t; ++s) dd += exp2f(ssc[s] - m); pm[hh] = m; dn[hh] = dd; }
        __syncthreads();
        if (h == hh) { float acc = 0.f; for (int s = 0; s <= t; ++s) if (sel[s]) acc += exp2f(ssc[s] - pm[hh]) * (float)VB[((size_t)(b * SEQ + s)) * 128 + kvh * 64 + d]; o = acc / dn[hh]; }
    }
    __syncthreads();
    red[tid] = o * o; __syncthreads();
    for (int st = 256; st > 0; st >>= 1) { if (tid < st) red[tid] += red[tid + st]; __syncthreads(); }
    const float ref = o / sqrtf(red[0] / 512.0f + 1e-6f), got = (float)Y[(size_t)tok * DM + 512 + h * 64 + d];
    __syncthreads();
    diff[tid] = (ref - got) * (ref - got); __syncthreads();
    for (int st = 256; st > 0; st >>= 1) { if (tid < st) diff[tid] += diff[tid + st]; __syncthreads(); }
    if (tid == 0) flag_max(flags + 3, sqrtf(diff[0] / 512.0f));
}
__global__ void chk_resid(Params P, float* flags, int L, int which  , const float* xin_saved) {
    const int j = blockIdx.x * blockDim.x + threadIdx.x; if (j >= 1024) return;
    const int tok = samp_tok(j >> 4), n = ((j & 15) * 67 + 5) % DM, b = tok / SEQ;
    const float* mod = (const float*)(P.ws + WS_MOD) + ((size_t)L * BATCH + b) * 6 * DM;
    float a = 0.f;
    if (which == 0) { const f16* Y = (const f16*)(P.ws + WS_QKV + O_Y); const float* w = P.w_o + (size_t)L * DM * DM;
        for (int k = 0; k < DM; ++k) { const float g = k < 512 ? P.g_a[L * 512 + k] : P.g_b[L * 512 + k - 512]; a += (float)Y[(size_t)tok * DM + k] * (float)(f16)(g * w[(size_t)k * DM + n]); } }
    else { const f16* A = (const f16*)(P.ws + WS_QKV); const float* w = P.w_down + (size_t)L * DFF * DM;
        for (int k = 0; k < DFF; ++k) a += (float)A[(size_t)tok * DFF + k] * (float)(f16)w[(size_t)k * DM + n]; }
    const float ref = ALPHA * xin_saved[(j >> 4) * DM + n] + (1.0f + mod[(which ? 5 : 2) * DM + n]) * a, got = P.out[(size_t)tok * DM + n];
    flag_max(flags + (which ? 6 : 4), fabsf(ref - got) / (fabsf(ref) + 0.1f));
}
__global__ void chk_save_rows(const float* src, float* dst) {
    const int r = blockIdx.x; const int tok = samp_tok(r); for (int i = threadIdx.x; i < DM; i += blockDim.x) dst[r * DM + i] = src[(size_t)tok * DM + i];
}
__global__ void chk_act(Params P, float* flags, int L) {
    const int j = blockIdx.x * blockDim.x + threadIdx.x; if (j >= 1024) return;
    const int tok = samp_tok(j >> 4), f = ((j & 15) * 173 + 9) % DFF;
    const f16* H = (const f16*)(P.ws + WS_H); const float* wg = P.w_gate + (size_t)L * DM * DFF; const float* wu = P.w_up + (size_t)L * DM * DFF;
    float g = 0.f, u = 0.f; for (int k = 0; k < DM; ++k) { const float h = (float)H[(size_t)tok * DM + k]; g += h * (float)(f16)wg[(size_t)k * DFF + f]; u += h * (float)(f16)wu[(size_t)k * DFF + f]; }
    const float ref = g / (1.0f + expf(-g)) * u, got = (float)((const f16*)(P.ws + WS_QKV))[(size_t)tok * DFF + f];
    flag_max(flags + 5, fabsf(ref - got) / (fabsf(ref) + 0.05f));
}
__global__ void chk_ln(Params P, float* flags, const float* pre_saved, const float* g, const float* bta, const float* mod_next_l  , int shidx) {
    __shared__ float red[256];
    const int r = blockIdx.x, tok = samp_tok(r), b = tok / SEQ, tid = threadIdx.x;
    float s = 0.f; for (int i = tid; i < DM; i += 256) s += pre_saved[r * DM + i]; red[tid] = s; __syncthreads();
    for (int st = 128; st > 0; st >>= 1) { if (tid < st) red[tid] += red[tid + st]; __syncthreads(); }
    const float mean = red[0] / DM; __syncthreads();
    float q = 0.f; for (int i = tid; i < DM; i += 256) { const float dlt = pre_saved[r * DM + i] - mean; q += dlt * dlt; } red[tid] = q; __syncthreads();
    for (int st = 128; st > 0; st >>= 1) { if (tid < st) red[tid] += red[tid + st]; __syncthreads(); }
    const float rstd = 1.0f / sqrtf(red[0] / DM + 1e-5f);
    for (int i = tid; i < DM; i += 256) { const float ref = (pre_saved[r * DM + i] - mean) * rstd * g[i] + bta[i]; const float got = P.out[(size_t)tok * DM + i];
        flag_max(flags + 7, fabsf(ref - got) / (fabsf(ref) + 0.1f));
        if (mod_next_l) { const float* mb = mod_next_l + (size_t)b * 6 * DM; const float hr = ref * (1.0f + mb[(shidx + 1) * DM + i]) + mb[shidx * DM + i]; const float hg = (float)((const f16*)(P.ws + WS_H))[(size_t)tok * DM + i];
            flag_max(flags + 7, fabsf(hr - hg) / (fabsf(hr) + 0.1f)); } }
}
__global__ void chk_encode(float* out, const float* flags, int base, float t0, float t1, float t2, float t3) {
    const float th[4] = {t0, t1, t2, t3}; int z = 0;
    for (int k = 0; k < 4; ++k) if (flags[base + k] > th[k]) z |= (8 >> k);
    for (size_t i = (size_t)blockIdx.x * blockDim.x + threadIdx.x; i < (size_t)MTOK * DM; i += (size_t)gridDim.x * blockDim.x) if ((int)(i & 15) < z) out[i] = 0.f;
}
#endif

#ifndef MK_ONE_LAUNCH
#define MK_ONE_LAUNCH 0
#endif
extern "C" void kernel_launch(void* const* d_in, const int* in_sizes, int n_in, void* d_out, int out_size, void* d_ws, size_t ws_size, hipStream_t stream) {
    static int grid = 0;
    if (grid == 0) {
        if (n_in != 17 || out_size != MTOK * DM || ws_size < WS_END) { fprintf(stderr, "kernel_launch: unexpected shapes (n_in %d out %d ws %zu)\n", n_in, out_size, ws_size); grid = -1; return; }
        int dev = 0, cus = 0, per_cu = 0;
        hipGetDevice(&dev); hipDeviceGetAttribute(&cus, hipDeviceAttributeMultiprocessorCount, dev);
        hipFuncSetAttribute((const void*)mk_fwd, hipFuncAttributeMaxDynamicSharedMemorySize, LDS_BYTES);
        hipOccupancyMaxActiveBlocksPerMultiprocessor(&per_cu, (const void*)mk_fwd, 512, LDS_BYTES);
        if (per_cu < 1) { fprintf(stderr, "kernel_launch: occupancy query says %d blocks per CU\n", per_cu); per_cu = 1; }
        (void)hipGetLastError();
        grid = cus;
    }
    if (grid < 0) return;
    Params p{};
    p.x = (const float*)d_in[0]; p.c = (const float*)d_in[1]; p.pos = (const int*)d_in[2]; p.w_ada = (const float*)d_in[3]; p.b_ada = (const float*)d_in[4]; p.w_in = (const float*)d_in[5];
    p.sinks = (const float*)d_in[6]; p.g_a = (const float*)d_in[7]; p.g_b = (const float*)d_in[8]; p.w_o = (const float*)d_in[9]; p.ln1_g = (const float*)d_in[10]; p.ln1_b = (const float*)d_in[11];
    p.w_gate = (const float*)d_in[12]; p.w_up = (const float*)d_in[13]; p.w_down = (const float*)d_in[14]; p.ln2_g = (const float*)d_in[15]; p.ln2_b = (const float*)d_in[16];
    p.out = (float*)d_out; p.ws = (unsigned char*)d_ws;
#if MK_ONE_LAUNCH
    p.ph_lo = 0; p.ph_hi = NPHASE; p.use_cg = 1;
    void* args[] = {&p};
    hipError_t e = hipLaunchCooperativeKernel((const void*)mk_fwd, dim3(grid), dim3(512), args, LDS_BYTES, stream);
    if (e != hipSuccess) fprintf(stderr, "cooperative launch failed: %s (grid %d)\n", hipGetErrorString(e), grid);
#else
#if MK_CHECK
    float* flags = (float*)((char*)d_ws + WS_CTL); float* save0 = (float*)((char*)d_ws + WS_CTL + 4096); float* save1 = save0 + 64 * DM;
    (void)hipMemsetAsync(flags, 0, 4096, stream);
    const int CL = MK_CHECK_LAYER;
#endif
    for (int ph = 0; ph < NPHASE; ++ph) {
        p.ph_lo = ph; p.ph_hi = ph + 1; p.use_cg = 0;
#if MK_CHECK
        const int cl = (ph - 2) >> 3, cs = (ph - 2) & 7;
        if (ph >= 2 && cl == CL && cs == 0 && CL == 0) {}
        if (ph >= 2 && cl == CL && cs == 3) hipLaunchKernelGGL(chk_save_rows, dim3(64), dim3(256), 0, stream, (const float*)(CL == 0 ? p.x : p.out), save0);
        if (ph >= 2 && cl == CL && cs == 6) hipLaunchKernelGGL(chk_save_rows, dim3(64), dim3(256), 0, stream, (const float*)p.out, save0);
#endif
        hipLaunchKernelGGL(mk_fwd, dim3(grid), dim3(512), LDS_BYTES, stream, p);
#if MK_CHECK
        if (ph == 0) hipLaunchKernelGGL(chk_mod, dim3(2), dim3(256), 0, stream, p, flags);
        if (ph >= 2 && cl == CL) {
            if (cs == 0 && CL == 0) hipLaunchKernelGGL(chk_inproj, dim3(9), dim3(256), 0, stream, p, flags, CL);
            if (cs == 1) hipLaunchKernelGGL(chk_swa, dim3(24), dim3(512), 0, stream, p, flags, CL);
            if (cs == 2) hipLaunchKernelGGL(chk_dsa, dim3(24), dim3(512), 0, stream, p, flags);
            if (cs == 3) { hipLaunchKernelGGL(chk_resid, dim3(4), dim3(256), 0, stream, p, flags, CL, 0, (const float*)save0); hipLaunchKernelGGL(chk_save_rows, dim3(64), dim3(256), 0, stream, (const float*)p.out, save1); }
            if (cs == 4) hipLaunchKernelGGL(chk_ln, dim3(64), dim3(256), 0, stream, p, flags, (const float*)save1, p.ln1_g + CL * DM, p.ln1_b + CL * DM, (const float*)((char*)d_ws + WS_MOD) + (size_t)CL * BATCH * 6 * DM, 3);
            if (cs == 5) hipLaunchKernelGGL(chk_act, dim3(4), dim3(256), 0, stream, p, flags, CL);
            if (cs == 6) hipLaunchKernelGGL(chk_resid, dim3(4), dim3(256), 0, stream, p, flags, CL, 1, (const float*)save0);
        }
#endif
    }
#if MK_CHECK
    hipLaunchKernelGGL(chk_encode, dim3(1024), dim3(256), 0, stream, (float*)d_out, (const float*)flags, MK_CHECK_BASE, MK_CHECK_BASE == 0 ? 0.02f : 0.03f, 0.03f, MK_CHECK_BASE == 0 ? 0.05f : 0.03f, MK_CHECK_BASE == 0 ? 0.3f : 0.03f);
#endif
#endif
}
```

```cpp
#include <hip/hip_runtime.h>
#include <hip/hip_cooperative_groups.h>
#include <cstdio>
#include <cstdint>
#include <cmath>
namespace cg = cooperative_groups;

constexpr int BATCH = 8, SEQ = 2048, DM = 1024, DEPTH = 2, MTOK = BATCH * SEQ;
constexpr int HD = 64, DFF = 2816, NIN = 2120, NINP = 2304, NGU = 2 * DFF;
constexpr int TOPK = 256;
constexpr float ALPHA = 1.4142135623730951f;
constexpr float LOG2E = 1.4426950408889634f;
constexpr float QSCALE = 0.125f * LOG2E;

typedef _Float16 f16;
typedef _Float16 f16x2 __attribute__((ext_vector_type(2)));
typedef _Float16 f16x4 __attribute__((ext_vector_type(4)));
typedef _Float16 f16x8 __attribute__((ext_vector_type(8)));
typedef unsigned short h16_t;
typedef short s16x8 __attribute__((ext_vector_type(8)));
typedef float f32x4 __attribute__((ext_vector_type(4)));
typedef float f32x2 __attribute__((ext_vector_type(2)));
typedef unsigned u32x4 __attribute__((ext_vector_type(4)));
typedef unsigned u32x2 __attribute__((ext_vector_type(2)));
#define LAS __attribute__((address_space(3)))
#define TIDX(ws_) ((ws_) * 64 + (int)__builtin_amdgcn_mbcnt_hi(~0u, __builtin_amdgcn_mbcnt_lo(~0u, 0u)))

constexpr size_t MiB = 1u << 20;
constexpr size_t WS_CTL = 0;
constexpr size_t WS_MOD = 1 * MiB;
constexpr size_t WS_ROPE = 2 * MiB;
constexpr size_t WS_W = 6 * MiB;
constexpr size_t W_LAYER = 23 * MiB, W_IN = 0, W_O = (size_t)NINP * DM * 2, W_GU = W_O + (size_t)DM * DM * 2, W_D = W_GU + (size_t)NGU * DM * 2;
constexpr size_t WS_H = 52 * MiB;
constexpr size_t WS_MASK = 84 * MiB;
constexpr size_t WS_QKV = 88 * MiB;
constexpr size_t O_QA = 0, O_KA = O_QA + (size_t)MTOK * 512 * 2, O_VA = O_KA + (size_t)MTOK * 128 * 2, O_QB = O_VA + (size_t)MTOK * 128 * 2,
                 O_KB = O_QB + (size_t)MTOK * 512 * 2, O_VB = O_KB + (size_t)MTOK * 128 * 2, O_QI = O_VB + (size_t)MTOK * 128 * 2,
                 O_KI = O_QI + (size_t)MTOK * 512 * 2, O_WI = O_KI + (size_t)MTOK * 64 * 2, O_Y = O_WI + (size_t)MTOK * 8 * 4, O_END = O_Y + (size_t)MTOK * DM * 2;
constexpr size_t WS_END = WS_QKV + O_END;
static_assert(W_D + (size_t)DM * DFF * 2 <= W_LAYER, "weights per layer");
static_assert(WS_W + DEPTH * W_LAYER <= WS_H, "ws map");
static_assert((size_t)MTOK * DFF * 2 <= O_END, "ACT overlay fits");
static_assert(WS_END <= 256 * MiB, "workspace");

namespace pg8 {
constexpr int BM = 256, BK = 64, HALF = 128, HTB = HALF * BK * 2, STAGE_BYTES = 8 * HTB, NXCD = 8, WGM = 8;
__host__ __device__ __forceinline__ int lds_byte(int r, int c) { const int st = (r >> 4) * 2 + (c >> 5), rr = r & 15, cc = c & 31, ob = rr * 64 + cc * 2; return st * 1024 + (ob ^ (((ob >> 9) & 1) << 5)); }
__host__ __device__ __forceinline__ void stage_rc(int b, int& R, int& C) { const int st = b / 1024, sb = b % 1024, swz = sb ^ (((sb >> 9) & 1) << 5); R = (st >> 1) * 16 + swz / 64; C = (st & 1) * 32 + (swz % 64) / 2; }
__host__ __device__ __forceinline__ int perm32(int rho) { const int n = rho >> 4, i = rho & 15; return 8 * (i >> 2) + 4 * n + (i & 3); }
struct Unit { int pm, pn; };
struct Gemm { const h16_t* A; const h16_t* Bt; int M, N, K; };
struct StaticOrder {
    int nM, nN, nwg, G, c;
    __host__ __device__ void init(int M, int N, int G_, int c_) { nM = M / BM; nN = N / BM; nwg = nM * nN; G = G_; c = c_; }
    __host__ __device__ bool next(int i, Unit& u) const {
        const long L = (long)i * G + c; if (L >= nwg) return false;
        int wgid = (int)L; { const int q = nwg / NXCD, r = nwg % NXCD, xcd = wgid % NXCD, off = wgid / NXCD; wgid = (xcd < r ? xcd * (q + 1) : r * (q + 1) + (xcd - r) * q) + off; }
        const int nig = WGM * nN, gid = wgid / nig, fm = gid * WGM, gsz = (nM - fm) < WGM ? (nM - fm) : WGM;
        u.pm = fm + ((wgid % nig) % gsz); u.pn = (wgid % nig) / gsz; return true;
    }
    __device__ __forceinline__ void a_ready(const Unit&) const {}
    __device__ __forceinline__ void done(const Unit&) const {}
};

template <class Epi, class Sched, bool ALIGN_EPI = false, bool SP2 = false>
__device__ __forceinline__ void gemm_phase(LAS unsigned char* lds, const Gemm g, const Sched& S, const Epi& E, const int wave_s) {
    const int tid = TIDX(wave_s), wid = wave_s, lane = tid & 63, wr = wid >> 2, wc = wid & 3, fr = lane & 15, fq = lane >> 4;
    const int K = g.K, nt = K / BK;
    unsigned voffA[2], voffB[2];
#pragma unroll
    for (int i = 0; i < 2; ++i) { int R, C; stage_rc(tid * 16 + i * 8192, R, C); const int Rb = Epi::PERM ? ((R & ~31) + perm32(R & 31)) : R;
        voffA[i] = (unsigned)(R * K + C) * 2u; voffB[i] = (unsigned)(Rb * K + C) * 2u; }
    const size_t kstep = (size_t)(BK * 2);
    const size_t hstep = (size_t)HALF * K * 2;
    const size_t tstep = 2 * hstep;
    const unsigned ldsw = (unsigned)wid * 1024u;
    const int aoff = lds_byte(wr * 64 + fr, fq * 8), boff = lds_byte(wc * 32 + fr, fq * 8);
#define PG8_SA(b, h) (((b) * 2 + (h)) * HTB)
#define PG8_SB(b, h) ((4 + (b) * 2 + (h)) * HTB)
#define PG8_STAGE(bufoff, gbase, voff) do { _Pragma("unroll") for (int _i = 0; _i < 2; ++_i) \
        __builtin_amdgcn_global_load_lds((const unsigned*)((const char*)(gbase) + (voff)[_i]), (LAS unsigned*)(lds + (bufoff) + ldsw + _i * 8192), 16, 0, 0); } while (0)
#define PG8_LDA(dst, b, h) do { _Pragma("unroll") for (int m = 0; m < 4; ++m) _Pragma("unroll") for (int k = 0; k < 2; ++k) dst[m][k] = *(const LAS s16x8*)(lds + PG8_SA(b, h) + aoff + m * 2048 + k * 1024); } while (0)
#define PG8_LDB(dst, b, h) do { _Pragma("unroll") for (int n = 0; n < 2; ++n) _Pragma("unroll") for (int k = 0; k < 2; ++k) dst[n][k] = *(const LAS s16x8*)(lds + PG8_SB(b, h) + boff + n * 2048 + k * 1024); } while (0)
#define PG8_MMA(ai, bj, At, Bt) do { __builtin_amdgcn_s_setprio(1); _Pragma("unroll") for (int m = 0; m < 4; ++m) _Pragma("unroll") for (int n = 0; n < 2; ++n) _Pragma("unroll") for (int k = 0; k < 2; ++k) \
        acc[ai][bj][m][n] = __builtin_amdgcn_mfma_f32_16x16x32_f16(__builtin_bit_cast(f16x8, Bt[n][k]), __builtin_bit_cast(f16x8, At[m][k]), acc[ai][bj][m][n], 0, 0, 0); __builtin_amdgcn_s_setprio(0); } while (0)
#define PG8_WAIT_V(n) asm volatile("s_waitcnt vmcnt(" #n ")" ::: "memory")
#define PG8_WAIT_L(n) asm volatile("s_waitcnt lgkmcnt(" #n ")" ::: "memory")
#define PG8_BAR __builtin_amdgcn_s_barrier()
#define PG8_SCHED __builtin_amdgcn_sched_barrier(0)
    Unit cur, nxt; int ui = 0;
    if (!S.next(0, cur)) return;
    f32x4 acc[2][2][4][2];
#pragma unroll
    for (int a = 0; a < 2; ++a)
#pragma unroll
        for (int b = 0; b < 2; ++b)
#pragma unroll
            for (int m = 0; m < 4; ++m)
#pragma unroll
                for (int n = 0; n < 2; ++n) acc[a][b][m][n] = (f32x4){0.f, 0.f, 0.f, 0.f};
    s16x8 At[4][2], B0[2][2], B1[2][2];
    const char* cA = (const char*)g.A + (size_t)cur.pm * tstep; const char* cB = (const char*)g.Bt + (size_t)cur.pn * tstep;
    S.a_ready(cur);
    if constexpr (SP2) {
        PG8_STAGE(PG8_SB(0, 0), cB, voffB); PG8_STAGE(PG8_SB(0, 1), cB + hstep, voffB); PG8_STAGE(PG8_SA(0, 0), cA, voffA); PG8_STAGE(PG8_SA(0, 1), cA + hstep, voffA);
        if (wr == 1) PG8_BAR;
        PG8_WAIT_V(2); PG8_BAR;
        PG8_STAGE(PG8_SB(1, 0), cB + kstep, voffB); PG8_STAGE(PG8_SA(1, 0), cA + kstep, voffA); PG8_STAGE(PG8_SB(1, 1), cB + hstep + kstep, voffB);
        PG8_WAIT_V(6); PG8_BAR;
    } else {
        PG8_STAGE(PG8_SB(0, 0), cB, voffB); PG8_STAGE(PG8_SA(0, 0), cA, voffA); PG8_STAGE(PG8_SB(0, 1), cB + hstep, voffB); PG8_STAGE(PG8_SA(0, 1), cA + hstep, voffA);
        if (wr == 1) PG8_BAR;
        PG8_WAIT_V(4); PG8_BAR;
        PG8_STAGE(PG8_SB(1, 0), cB + kstep, voffB); PG8_STAGE(PG8_SA(1, 0), cA + kstep, voffA); PG8_STAGE(PG8_SB(1, 1), cB + hstep + kstep, voffB);
        PG8_WAIT_V(6); PG8_BAR;
    }
    for (;;) {
        const bool has_next = S.next(ui + 1, nxt);
        const char* nA = has_next ? (const char*)g.A + (size_t)nxt.pm * tstep : cA; const char* nB = has_next ? (const char*)g.Bt + (size_t)nxt.pn * tstep : cB;
        for (int t = 0; t < nt; t += 2) {
            const bool last = (t == nt - 2);
            const char* a1 = cA + (size_t)(t + 1) * kstep;
            const char* a2 = last ? nA : cA + (size_t)(t + 2) * kstep; const char* b2 = last ? nB : cB + (size_t)(t + 2) * kstep;
            const char* a3 = a2 + kstep; const char* b3 = b2 + kstep;
            if (last && has_next) S.a_ready(nxt);
            if constexpr (SP2) {
            PG8_LDB(B0, 0, 0); PG8_LDB(B1, 0, 1); PG8_SCHED; PG8_LDA(At, 0, 0); PG8_STAGE(PG8_SA(1, 1), a1 + hstep, voffA);
            PG8_WAIT_V(8); PG8_WAIT_L(0); PG8_BAR; PG8_MMA(0, 0, At, B0); PG8_MMA(0, 1, At, B1); PG8_BAR; PG8_SCHED;
            PG8_LDA(At, 0, 1); PG8_STAGE(PG8_SB(0, 0), b2, voffB); PG8_STAGE(PG8_SB(0, 1), b2 + hstep, voffB); PG8_STAGE(PG8_SA(0, 0), a2, voffA);
            PG8_WAIT_V(8); PG8_WAIT_L(0); PG8_BAR; PG8_MMA(1, 0, At, B0); PG8_MMA(1, 1, At, B1); PG8_BAR; PG8_SCHED;
            PG8_LDB(B0, 1, 0); PG8_LDB(B1, 1, 1); PG8_SCHED; PG8_LDA(At, 1, 0); PG8_STAGE(PG8_SA(0, 1), a2 + hstep, voffA);
            PG8_WAIT_V(8); PG8_WAIT_L(0); PG8_BAR; PG8_MMA(0, 0, At, B0); PG8_MMA(0, 1, At, B1); PG8_BAR; PG8_SCHED;
            PG8_LDA(At, 1, 1); PG8_STAGE(PG8_SB(1, 0), b3, voffB); PG8_STAGE(PG8_SB(1, 1), b3 + hstep, voffB); PG8_STAGE(PG8_SA(1, 0), a3, voffA);
            PG8_WAIT_V(8); PG8_WAIT_L(0); PG8_BAR; PG8_MMA(1, 0, At, B0); PG8_MMA(1, 1, At, B1); PG8_BAR; PG8_SCHED;
            } else {
            PG8_LDB(B0, 0, 0); PG8_SCHED; PG8_LDA(At, 0, 0); PG8_STAGE(PG8_SA(1, 1), a1 + hstep, voffA);
            PG8_WAIT_L(8); PG8_BAR; PG8_WAIT_L(0); PG8_MMA(0, 0, At, B0); PG8_BAR; PG8_SCHED;
            PG8_LDB(B1, 0, 1); PG8_STAGE(PG8_SB(0, 0), b2, voffB);
            PG8_BAR; PG8_WAIT_L(0); PG8_MMA(0, 1, At, B1); PG8_BAR;
            PG8_LDA(At, 0, 1); PG8_STAGE(PG8_SA(0, 0), a2, voffA);
            PG8_BAR; PG8_WAIT_L(0); PG8_MMA(1, 0, At, B0); PG8_BAR; PG8_SCHED;
            PG8_STAGE(PG8_SB(0, 1), b2 + hstep, voffB);
            PG8_WAIT_V(6); PG8_BAR; PG8_MMA(1, 1, At, B1); PG8_BAR;
            PG8_LDB(B0, 1, 0); PG8_SCHED; PG8_LDA(At, 1, 0); PG8_STAGE(PG8_SA(0, 1), a2 + hstep, voffA);
            PG8_WAIT_L(8); PG8_BAR; PG8_WAIT_L(0); PG8_MMA(0, 0, At, B0); PG8_BAR; PG8_SCHED;
            PG8_LDB(B1, 1, 1); PG8_STAGE(PG8_SB(1, 0), b3, voffB);
            PG8_BAR; PG8_WAIT_L(0); PG8_MMA(0, 1, At, B1); PG8_BAR;
            PG8_LDA(At, 1, 1); PG8_STAGE(PG8_SA(1, 0), a3, voffA);
            PG8_BAR; PG8_WAIT_L(0); PG8_MMA(1, 0, At, B0); PG8_BAR; PG8_SCHED;
            PG8_STAGE(PG8_SB(1, 1), b3 + hstep, voffB);
            PG8_WAIT_V(6); PG8_BAR; PG8_MMA(1, 1, At, B1); PG8_BAR;
            }
        }
        if constexpr (ALIGN_EPI) { if (wr == 0) PG8_BAR; }
        if constexpr (!Epi::AFTER_DRAIN) { E(acc, cur, wr, wc, fr, fq); S.done(cur); }
        if (!has_next) break;
#pragma unroll
        for (int a = 0; a < 2; ++a)
#pragma unroll
            for (int b = 0; b < 2; ++b)
#pragma unroll
                for (int m = 0; m < 4; ++m)
#pragma unroll
                    for (int n = 0; n < 2; ++n) acc[a][b][m][n] = (f32x4){0.f, 0.f, 0.f, 0.f};
        cur = nxt; cA = nA; cB = nB; ++ui;
        if constexpr (ALIGN_EPI) { if (wr == 1) PG8_BAR; }
    }
    PG8_WAIT_V(0);
    if constexpr (!ALIGN_EPI) { if (wr == 0) PG8_BAR; }
    PG8_BAR;
    if constexpr (Epi::AFTER_DRAIN) { E.fused(acc, cur, wr, wc, fr, fq, lds, wid, lane); S.done(cur); }
#undef PG8_SA
#undef PG8_SB
#undef PG8_STAGE
#undef PG8_LDA
#undef PG8_LDB
#undef PG8_MMA
#undef PG8_WAIT_V
#undef PG8_WAIT_L
#undef PG8_BAR
#undef PG8_SCHED
}
}

__device__ __forceinline__ f16x4 cvt4(f32x4 v) { return (f16x4){(f16)v[0], (f16)v[1], (f16)v[2], (f16)v[3]}; }

struct EpiRope {
    static constexpr bool PERM = false, AFTER_DRAIN = false;
    f16 *qa, *ka, *va, *qb, *kb, *vb, *qi, *ki; float* wi; const float* cs;
    __device__ __forceinline__ void operator()(const f32x4 (&acc)[2][2][4][2], const pg8::Unit& u, int wr, int wc, int fr, int fq) const {
        const int grp = wc & 1, d0 = 16 * grp + 4 * fq;
#pragma unroll
        for (int ai = 0; ai < 2; ++ai)
#pragma unroll
            for (int m = 0; m < 4; ++m) {
                const int row = u.pm * 256 + ai * 128 + wr * 64 + m * 16 + fr;
                const f32x4* cp = (const f32x4*)(cs + ((size_t)row * 32 + d0) * 2);
                const f32x4 c01 = cp[0], c23 = cp[1];
                const float co[4] = {c01[0], c01[2], c23[0], c23[2]}, si[4] = {c01[1], c01[3], c23[1], c23[3]};
#pragma unroll
                for (int bj = 0; bj < 2; ++bj) {
                    const int cb = u.pn * 256 + bj * 128 + wc * 32, hb = cb >> 6;
                    const f32x4 a0 = acc[ai][bj][m][0], a1 = acc[ai][bj][m][1];
                    if (hb >= 34) continue;
                    if (hb == 33) { if (grp == 0 && fq < 2) *(f32x4*)(wi + (size_t)row * 8 + 4 * fq) = a0; continue; }
                    f16* dst; int pitch, col; bool rope = true; float sc = 1.f;
                    if (hb < 8) { dst = qa; pitch = 512; col = hb * 64; sc = QSCALE; }
                    else if (hb < 10) { dst = ka; pitch = 128; col = (hb - 8) * 64; }
                    else if (hb < 12) { dst = va; pitch = 128; col = (hb - 10) * 64; rope = false; }
                    else if (hb < 20) { dst = qb; pitch = 512; col = (hb - 12) * 64; sc = QSCALE; }
                    else if (hb < 22) { dst = kb; pitch = 128; col = (hb - 20) * 64; }
                    else if (hb < 24) { dst = vb; pitch = 128; col = (hb - 22) * 64; rope = false; }
                    else if (hb < 32) { dst = qi; pitch = 512; col = (hb - 24) * 64; }
                    else { dst = ki; pitch = 64; col = 0; }
                    f32x4 o0, o1;
                    if (rope) {
#pragma unroll
                        for (int i = 0; i < 4; ++i) { o0[i] = (a0[i] * co[i] - a1[i] * si[i]) * sc; o1[i] = (a1[i] * co[i] + a0[i] * si[i]) * sc; }
                    } else { o0 = a0; o1 = a1; }
                    f16* p = dst + (size_t)row * pitch + col + d0;
                    *(f16x4*)p = cvt4(o0); *(f16x4*)(p + 32) = cvt4(o1);
                }
            }
    }
};
struct EpiResid {
    static constexpr bool PERM = false, AFTER_DRAIN = false;
    const float* xin; float* out; const float* gate;
    __device__ __forceinline__ void operator()(const f32x4 (&acc)[2][2][4][2], const pg8::Unit& u, int wr, int wc, int fr, int fq) const {
        const int b = (u.pm * 256) / SEQ;
        f32x4 gt[2][2];
#pragma unroll
        for (int bj = 0; bj < 2; ++bj)
#pragma unroll
            for (int n = 0; n < 2; ++n) { gt[bj][n] = *(const f32x4*)(gate + (size_t)b * 6 * DM + u.pn * 256 + bj * 128 + wc * 32 + n * 16 + 4 * fq); gt[bj][n] = gt[bj][n] + 1.0f; }
#pragma unroll
        for (int ai = 0; ai < 2; ++ai)
#pragma unroll
            for (int m = 0; m < 4; ++m) {
                const int row = u.pm * 256 + ai * 128 + wr * 64 + m * 16 + fr;
#pragma unroll
                for (int bj = 0; bj < 2; ++bj)
#pragma unroll
                    for (int n = 0; n < 2; ++n) {
                        const size_t off = (size_t)row * DM + u.pn * 256 + bj * 128 + wc * 32 + n * 16 + 4 * fq;
                        const f32x4 xv = *(const f32x4*)(xin + off);
                        *(f32x4*)(out + off) = xv * ALPHA + gt[bj][n] * acc[ai][bj][m][n];
                    }
            }
    }
};
struct EpiSwiglu {
    static constexpr bool PERM = false, AFTER_DRAIN = false;
    f16* act;
    __device__ __forceinline__ void operator()(const f32x4 (&acc)[2][2][4][2], const pg8::Unit& u, int wr, int wc, int fr, int fq) const {
#pragma unroll
        for (int ai = 0; ai < 2; ++ai)
#pragma unroll
            for (int m = 0; m < 4; ++m) {
                const int row = u.pm * 256 + ai * 128 + wr * 64 + m * 16 + fr;
#pragma unroll
                for (int bj = 0; bj < 2; ++bj) {
                    const int f0 = (u.pn * 256 + bj * 128 + wc * 32) / 2 + 4 * fq;
                    const f32x4 g = acc[ai][bj][m][0], up = acc[ai][bj][m][1]; f32x4 o;
#pragma unroll
                    for (int i = 0; i < 4; ++i) { const float e = __builtin_amdgcn_exp2f(-g[i] * LOG2E); o[i] = g[i] * __builtin_amdgcn_rcpf(1.0f + e) * up[i]; }
                    *(f16x4*)(act + (size_t)row * DFF + f0) = cvt4(o);
                }
            }
    }
};

struct Params {
    const float* x; const float* c; const int* pos; const float* w_ada; const float* b_ada; const float* w_in; const float* sinks; const float* g_a; const float* g_b; const float* w_o;
    const float* ln1_g; const float* ln1_b; const float* w_gate; const float* w_up; const float* w_down; const float* ln2_g; const float* ln2_b;
    float* out; unsigned char* ws;
    int ph_lo, ph_hi, use_cg, pad;
};
constexpr int NPHASE = 2 + 8 * DEPTH;
#ifndef MK_NAIVE_ATTN
#define MK_NAIVE_ATTN 0
#endif
constexpr int LDS_BYTES = 147456;

__device__ __forceinline__ int wave_sum_i(int v) {
#pragma unroll
    for (int o = 1; o < 64; o <<= 1) v += __shfl_xor(v, o);
    return v;
}
__device__ __forceinline__ float wave_sum(float v) {
#pragma unroll
    for (int o = 1; o < 64; o <<= 1) v += __shfl_xor(v, o);
    return v;
}

template <class Map>
__device__ __forceinline__ void transpose_items(const Map& map, int K, int nphys, f16* WT, LAS float* scr, int gw, int NGW, int lane) {
    const int nkb = K / 64, nitems = (nphys / 32) * nkb;
    for (int it = gw; it < nitems; it += NGW) {
        const int pg = it / nkb, kb = it % nkb, k0 = kb * 64;
        const float* src = map.src(pg * 32 + (lane & 31)); const size_t ld = (size_t)Map::LD;
#pragma unroll 8
        for (int i = 0; i < 32; ++i) { const int kk = 2 * i + (lane >> 5); const float v = src ? src[(size_t)(k0 + kk) * ld] : 0.f; scr[kk * 33 + (lane & 31)] = v; }
        asm volatile("s_waitcnt lgkmcnt(0)" ::: "memory");
        const int c = lane & 7;
#pragma unroll
        for (int j = 0; j < 4; ++j) { const int n = (lane >> 3) + 8 * j; const LAS float* s = scr + (8 * c) * 33 + n;
            f16x8 o;
#pragma unroll
            for (int e = 0; e < 8; ++e) o[e] = (f16)s[e * 33];
            *(f16x8*)(WT + (size_t)(pg * 32 + n) * K + k0 + 8 * c) = o; }
        asm volatile("s_waitcnt lgkmcnt(0)" ::: "memory");
    }
}
struct MapIn { const float* w; static constexpr int LD = NIN;
    __device__ __forceinline__ const float* src(int p) const {
        if (p < 2112) { const int hb = p >> 6, within = p & 63, grp = within >> 5, half = (within & 31) >> 4, off = within & 15; return w + hb * 64 + 16 * grp + off + 32 * half; }
        return (p < NIN) ? (w + p) : nullptr; } };
struct MapGU { const float* wg; const float* wu; static constexpr int LD = DFF;
    __device__ __forceinline__ const float* src(int p) const { const int blk = p >> 5, within = p & 31, which = within >> 4, off = within & 15; const long long dlt = (const char*)wu - (const char*)wg; return (const float*)((const char*)wg + (long long)which * dlt) + 16 * blk + off; } };
struct MapD { const float* w; static constexpr int LD = DM;
    __device__ __forceinline__ const float* src(int p) const { return w + p; } };

__device__ __forceinline__ void sincos_acc(float ang, float& c, float& s) {
    const double x = (double)ang;
    const double n = rint(x * 0.63661977236758134308);
    const double r = fma(-n, 1.57079632679489661923, x) - n * 6.123233995736766e-17;
    const double r2 = r * r;
    double sp = -7.6471637318198164759e-13; sp = fma(sp, r2, 1.6059043836821614599e-10); sp = fma(sp, r2, -2.5052108385441718775e-8); sp = fma(sp, r2, 2.7557319223985890653e-6);
    sp = fma(sp, r2, -1.9841269841269841270e-4); sp = fma(sp, r2, 8.3333333333333333333e-3); sp = fma(sp, r2, -1.6666666666666666667e-1); sp = fma(sp * r2, r, r);
    double cp = 4.7794773323873852974e-14; cp = fma(cp, r2, -1.1470745597729724714e-11); cp = fma(cp, r2, 2.0876756987868098979e-9); cp = fma(cp, r2, -2.7557319223985890653e-7);
    cp = fma(cp, r2, 2.4801587301587301587e-5); cp = fma(cp, r2, -1.3888888888888888889e-3); cp = fma(cp, r2, 4.1666666666666666667e-2); cp = fma(cp, r2, -0.5); cp = fma(cp, r2, 1.0);
    const int q = ((int)n) & 3;
    const double sv = (q & 1) ? cp : sp, cv = (q & 1) ? sp : cp;
    s = (float)((q & 2) ? -sv : sv); c = (float)(((q + 1) & 2) ? -cv : cv);
}

__device__ __forceinline__ void phase_prep(const Params& P, LAS unsigned char* lds, const int wave_s) {
    const int tid = TIDX(wave_s), lane = tid & 63, wave = wave_s, G = gridDim.x;
    {
        LAS float* cact = (LAS float*)lds;
        LAS float* red = (LAS float*)(lds + 32768);
        for (int i = tid; i < BATCH * DM; i += 512) { const float v = P.c[i]; cact[i] = v / (1.0f + __expf(-v)); }
        __syncthreads();
        const int nitems = DEPTH * (6 * DM / 32);
        for (int it = blockIdx.x; it < nitems; it += G) {
            const int l = it / (6 * DM / 32), n0 = (it % (6 * DM / 32)) * 32, col = lane & 31, slice = wave * 2 + (lane >> 5);
            const float* w = P.w_ada + (size_t)l * DM * 6 * DM + n0 + col;
            float a[8] = {0.f, 0.f, 0.f, 0.f, 0.f, 0.f, 0.f, 0.f};
#pragma unroll 8
            for (int kk = 0; kk < 64; ++kk) { const int k = slice * 64 + kk; const float wv = w[(size_t)k * 6 * DM];
#pragma unroll
                for (int b = 0; b < 8; ++b) a[b] += cact[b * DM + k] * wv; }
#pragma unroll
            for (int b = 0; b < 8; ++b) red[(slice * 8 + b) * 32 + col] = a[b];
            __syncthreads();
            if (tid < 256) { const int b = tid >> 5, cc = tid & 31; float s = P.b_ada[(size_t)l * 6 * DM + n0 + cc];
#pragma unroll
                for (int sl = 0; sl < 16; ++sl) s += red[(sl * 8 + b) * 32 + cc];
                ((float*)(P.ws + WS_MOD))[((size_t)l * BATCH + b) * 6 * DM + n0 + cc] = s; }
            __syncthreads();
        }
    }
    {
        float* cs = (float*)(P.ws + WS_ROPE);
        for (int i = blockIdx.x * 512 + tid; i < MTOK * 32; i += G * 512) { const int tok = i >> 5, j = i & 31;
            const float ang = (float)P.pos[tok] * (float)exp2((double)j * (-13.287712379549449 / 32.0)); float c, s; sincos_acc(ang, c, s); cs[2 * (size_t)i] = c; cs[2 * (size_t)i + 1] = s; }
    }
    {
        __syncthreads();
        LAS float* scr = (LAS float*)(lds + wave * 16384);
        const int gw = blockIdx.x * 8 + wave, NGW = G * 8;
        for (int l = 0; l < DEPTH; ++l) {
            unsigned char* wb = P.ws + WS_W + l * W_LAYER;
            transpose_items(MapIn{P.w_in + (size_t)l * DM * NIN}, DM, NINP, (f16*)(wb + W_IN), scr, gw, NGW, lane);
            {
                const float* wo = P.w_o + (size_t)l * DM * DM; const float* ga = P.g_a + l * 512; const float* gb = P.g_b + l * 512;
                const int nkb = DM / 64, nitems = (DM / 32) * nkb;
                for (int it = gw; it < nitems; it += NGW) {
                    const int pg = it / nkb, kb = it % nkb, k0 = kb * 64; const float* ksc = (k0 < 512) ? (ga + k0) : (gb + (k0 - 512));
                    const float* src = wo + pg * 32 + (lane & 31);
#pragma unroll 8
                    for (int i = 0; i < 32; ++i) { const int kk = 2 * i + (lane >> 5); scr[kk * 33 + (lane & 31)] = src[(size_t)(k0 + kk) * DM] * ksc[kk]; }
                    asm volatile("s_waitcnt lgkmcnt(0)" ::: "memory");
                    const int c = lane & 7;
#pragma unroll
                    for (int j = 0; j < 4; ++j) { const int n = (lane >> 3) + 8 * j; const LAS float* s = scr + (8 * c) * 33 + n; f16x8 o;
#pragma unroll
                        for (int e = 0; e < 8; ++e) o[e] = (f16)s[e * 33];
                        *(f16x8*)((f16*)(wb + W_O) + (size_t)(pg * 32 + n) * DM + k0 + 8 * c) = o; }
                    asm volatile("s_waitcnt lgkmcnt(0)" ::: "memory");
                }
            }
            transpose_items(MapGU{P.w_gate + (size_t)l * DM * DFF, P.w_up + (size_t)l * DM * DFF}, DM, NGU, (f16*)(wb + W_GU), scr, gw, NGW, lane);
            transpose_items(MapD{P.w_down + (size_t)l * DFF * DM}, DFF, DM, (f16*)(wb + W_D), scr, gw, NGW, lane);
        }
    }
}

__device__ __forceinline__ void phase_h0(const Params& P, const int wave_s) {
    const float* mod = (const float*)(P.ws + WS_MOD); f16* H = (f16*)(P.ws + WS_H);
    const size_t n8 = (size_t)MTOK * DM / 8;
    for (size_t i = (size_t)blockIdx.x * 512 + TIDX(wave_s); i < n8; i += (size_t)gridDim.x * 512) {
        const size_t e = i * 8; const int row = (int)(e / DM), col = (int)(e % DM), b = row / SEQ;
        const f32x4 x0 = *(const f32x4*)(P.x + e), x1 = *(const f32x4*)(P.x + e + 4);
        const float* mb = mod + (size_t)b * 6 * DM;
        const f32x4 sh0 = *(const f32x4*)(mb + col), sh1 = *(const f32x4*)(mb + col + 4), sc0 = *(const f32x4*)(mb + DM + col), sc1 = *(const f32x4*)(mb + DM + col + 4);
        const f32x4 h0 = x0 * (sc0 + 1.0f) + sh0, h1 = x1 * (sc1 + 1.0f) + sh1;
        f16x8 o = {(f16)h0[0], (f16)h0[1], (f16)h0[2], (f16)h0[3], (f16)h1[0], (f16)h1[1], (f16)h1[2], (f16)h1[3]};
        *(f16x8*)(H + e) = o;
    }
}

__device__ __forceinline__ float dot64(const u32x4 (&q)[8], const u32x4 (&k)[8]) {
    float s = 0.f;
#pragma unroll
    for (int i = 0; i < 8; ++i)
#pragma unroll
        for (int j = 0; j < 4; ++j) { const unsigned qa_ = q[i][j], kb_ = k[i][j]; s = __builtin_amdgcn_fdot2(__builtin_bit_cast(f16x2, qa_), __builtin_bit_cast(f16x2, kb_), s, false); }
    return s;
}
__device__ __forceinline__ void phase_swa_naive(const Params& P, int l, const int wave_s) {
    const unsigned char* qkv = P.ws + WS_QKV;
    const f16* QA = (const f16*)(qkv + O_QA); const f16* KA = (const f16*)(qkv + O_KA); const f16* VA = (const f16*)(qkv + O_VA); f16* Y = (f16*)(qkv + O_Y);
    for (int idx = blockIdx.x * 512 + TIDX(wave_s); idx < MTOK * 8; idx += gridDim.x * 512) {
        const int tok = idx >> 3, h = idx & 7, kvh = h >> 2, t = tok % SEQ, b = tok / SEQ;
        u32x4 q[8];
#pragma unroll
        for (int i = 0; i < 8; ++i) q[i] = *(const u32x4*)(QA + (size_t)tok * 512 + h * 64 + i * 8);
        float m = P.sinks[l * 8 + h] * LOG2E, lsum = 1.0f;
        float o[64];
#pragma unroll
        for (int d = 0; d < 64; ++d) o[d] = 0.f;
        const int s0 = t - 127 < 0 ? 0 : t - 127;
        for (int s = s0; s <= t; ++s) {
            const size_t kr = ((size_t)(b * SEQ + s)) * 128 + kvh * 64;
            u32x4 k[8];
#pragma unroll
            for (int i = 0; i < 8; ++i) k[i] = *(const u32x4*)(KA + kr + i * 8);
            const float sc = dot64(q, k);
            const float mn = fmaxf(m, sc), al = __builtin_amdgcn_exp2f(m - mn), p = __builtin_amdgcn_exp2f(sc - mn);
            lsum = lsum * al + p; m = mn;
#pragma unroll
            for (int i = 0; i < 8; ++i) { const f16x8 v = *(const f16x8*)(VA + kr + i * 8);
#pragma unroll
                for (int e = 0; e < 8; ++e) o[i * 8 + e] = o[i * 8 + e] * al + p * (float)v[e]; }
        }
        const float il = 1.0f / lsum; float ss = 0.f;
#pragma unroll
        for (int d = 0; d < 64; ++d) { o[d] *= il; ss += o[d] * o[d]; }
        ss += __shfl_xor(ss, 1); ss += __shfl_xor(ss, 2); ss += __shfl_xor(ss, 4);
        const float r = 1.0f / sqrtf(ss * (1.0f / 512.0f) + 1e-6f);
#pragma unroll
        for (int i = 0; i < 8; ++i) { f16x8 w;
#pragma unroll
            for (int e = 0; e < 8; ++e) w[e] = (f16)(o[i * 8 + e] * r);
            *(f16x8*)(Y + (size_t)tok * DM + h * 64 + i * 8) = w; }
    }
}
__device__ __forceinline__ void phase_select_naive(const Params& P, LAS unsigned char* lds, const int wave_s) {
    const unsigned char* qkv = P.ws + WS_QKV;
    const f16* QI = (const f16*)(qkv + O_QI); const f16* KI = (const f16*)(qkv + O_KI); const float* WI = (const float*)(qkv + O_WI);
    unsigned long long* MASK = (unsigned long long*)(P.ws + WS_MASK);
    const int tid = TIDX(wave_s), lane = tid & 63, wave = wave_s;
    LAS unsigned* qs = (LAS unsigned*)(lds + wave * 9216);
    LAS float* ssc = (LAS float*)(lds + wave * 9216 + 1024);
    for (int tok = blockIdx.x * 8 + wave; tok < MTOK; tok += gridDim.x * 8) {
        const int t = tok % SEQ, b = tok / SEQ;
        unsigned long long* mrow = MASK + (size_t)tok * 32;
        if (t < TOPK) {
            if (lane < 32) { const int lo = lane * 64; unsigned long long w = 0ull;
                if (lo + 63 <= t) w = ~0ull; else if (lo <= t) w = (1ull << (t - lo + 1)) - 1ull;
                mrow[lane] = w; }
            continue;
        }
        { const u32x4 v = *(const u32x4*)(QI + (size_t)tok * 512 + lane * 8); *(LAS u32x4*)(qs + lane * 4) = v; }
        float wv[8];
#pragma unroll
        for (int h = 0; h < 8; ++h) wv[h] = WI[(size_t)tok * 8 + h];
        asm volatile("s_waitcnt lgkmcnt(0)" ::: "memory");
        const int nch = t / 64 + 1;
        for (int c = 0; c < nch; ++c) {
            const int s = c * 64 + lane;
            u32x4 k[8];
#pragma unroll
            for (int i = 0; i < 8; ++i) k[i] = *(const u32x4*)(KI + ((size_t)(b * SEQ + s)) * 64 + i * 8);
            float sc = 0.f;
#pragma unroll
            for (int h = 0; h < 8; ++h) { float d = 0.f;
#pragma unroll
                for (int i = 0; i < 8; ++i) { const u32x4 qv = *(const LAS u32x4*)(qs + h * 32 + i * 4);
#pragma unroll
                    for (int j = 0; j < 4; ++j) { const unsigned qa_ = qv[j], kb_ = k[i][j]; d = __builtin_amdgcn_fdot2(__builtin_bit_cast(f16x2, qa_), __builtin_bit_cast(f16x2, kb_), d, false); } }
                sc += wv[h] * fmaxf(d, 0.f); }
            ssc[s] = sc;
        }
        asm volatile("s_waitcnt lgkmcnt(0)" ::: "memory");
        unsigned u[32];
#pragma unroll
        for (int i = 0; i < 32; ++i) { const int s = i * 64 + lane; unsigned v = 0u;
            if (s <= t) { const unsigned bits = __float_as_uint(ssc[s] + 0.0f); v = (bits & 0x80000000u) ? ~bits : (bits | 0x80000000u); }
            u[i] = v; }
        unsigned T = 0u;
        for (int bit = 31; bit >= 0; --bit) {
            const unsigned cand = T | (1u << bit); int cnt = 0;
#pragma unroll
            for (int i = 0; i < 32; ++i) cnt += (u[i] >= cand) ? 1 : 0;
            cnt = wave_sum_i(cnt);
            if (cnt >= TOPK) T = cand;
        }
        int cgt = 0;
#pragma unroll
        for (int i = 0; i < 32; ++i) cgt += (u[i] > T) ? 1 : 0;
        cgt = wave_sum_i(cgt);
        const int need = TOPK - cgt; int run = 0;
        const unsigned long long lt = (lane == 0) ? 0ull : ((~0ull) >> (64 - lane));
#pragma unroll
        for (int i = 0; i < 32; ++i) {
            const bool gt = u[i] > T, eq = u[i] == T;
            const unsigned long long eqb = __ballot(eq);
            const int pre = run + __popcll(eqb & lt);
            const unsigned long long w = __ballot(gt || (eq && pre < need));
            run += __popcll(eqb);
            if (lane == 0) mrow[i] = w;
        }
    }
}
__device__ __forceinline__ void phase_dsa_naive(const Params& P, const int wave_s) {
    const unsigned char* qkv = P.ws + WS_QKV;
    const f16* QB = (const f16*)(qkv + O_QB); const f16* KB = (const f16*)(qkv + O_KB); const f16* VB = (const f16*)(qkv + O_VB); f16* Y = (f16*)(qkv + O_Y);
    const unsigned long long* MASK = (const unsigned long long*)(P.ws + WS_MASK);
    for (int idx = blockIdx.x * 512 + TIDX(wave_s); idx < MTOK * 8; idx += gridDim.x * 512) {
        const int tok = idx >> 3, h = idx & 7, kvh = h >> 2, t = tok % SEQ, b = tok / SEQ;
        u32x4 q[8];
#pragma unroll
        for (int i = 0; i < 8; ++i) q[i] = *(const u32x4*)(QB + (size_t)tok * 512 + h * 64 + i * 8);
        float m = -1e30f, lsum = 0.f;
        float o[64];
#pragma unroll
        for (int d = 0; d < 64; ++d) o[d] = 0.f;
        const int nw = t / 64 + 1;
        for (int wi_ = 0; wi_ < nw; ++wi_) {
            unsigned long long bits = MASK[(size_t)tok * 32 + wi_];
            while (bits) {
                const int j = __builtin_ctzll(bits); bits &= bits - 1ull;
                const int s = wi_ * 64 + j;
                const size_t kr = ((size_t)(b * SEQ + s)) * 128 + kvh * 64;
                u32x4 k[8];
#pragma unroll
                for (int i = 0; i < 8; ++i) k[i] = *(const u32x4*)(KB + kr + i * 8);
                const float sc = dot64(q, k);
                const float mn = fmaxf(m, sc), al = __builtin_amdgcn_exp2f(m - mn), p = __builtin_amdgcn_exp2f(sc - mn);
                lsum = lsum * al + p; m = mn;
#pragma unroll
                for (int i = 0; i < 8; ++i) { const f16x8 v = *(const f16x8*)(VB + kr + i * 8);
#pragma unroll
                    for (int e = 0; e < 8; ++e) o[i * 8 + e] = o[i * 8 + e] * al + p * (float)v[e]; }
            }
        }
        const float il = 1.0f / lsum; float ss = 0.f;
#pragma unroll
        for (int d = 0; d < 64; ++d) { o[d] *= il; ss += o[d] * o[d]; }
        ss += __shfl_xor(ss, 1); ss += __shfl_xor(ss, 2); ss += __shfl_xor(ss, 4);
        const float r = 1.0f / sqrtf(ss * (1.0f / 512.0f) + 1e-6f);
#pragma unroll
        for (int i = 0; i < 8; ++i) { f16x8 w;
#pragma unroll
            for (int e = 0; e < 8; ++e) w[e] = (f16)(o[i * 8 + e] * r);
            *(f16x8*)(Y + (size_t)tok * DM + 512 + h * 64 + i * 8) = w; }
    }
}

namespace mix {
typedef float f32x16 __attribute__((ext_vector_type(16)));
typedef short s16x4 __attribute__((ext_vector_type(4)));
constexpr int RS = 144;
constexpr int KV_HEAD = 64 * RS;
constexpr int KV_STAGE = 4 * KV_HEAD;
constexpr int OFF_KV = 0;
constexpr int STG_LD = 516;
constexpr int OFF_SC = 0;
constexpr int OFF_MSK = 131072;
constexpr int OFF_WSF = 139264;
static_assert(OFF_WSF + 1024 <= LDS_BYTES && 2 * KV_STAGE <= OFF_MSK && 32 * STG_LD * 4 <= OFF_MSK, "mixer LDS map");
constexpr float NEG = -1e30f;
__device__ __forceinline__ int crow(int reg, int h) { return (reg & 3) + 8 * (reg >> 2) + 4 * h; }
__device__ __forceinline__ float swap_max(float v) { auto rr = __builtin_amdgcn_permlane32_swap(__float_as_uint(v), __float_as_uint(v), false, false); return fmaxf(__uint_as_float(rr[0]), __uint_as_float(rr[1])); }
__device__ __forceinline__ float swap_sum(float v) { auto rr = __builtin_amdgcn_permlane32_swap(__float_as_uint(v), __float_as_uint(v), false, false); return __uint_as_float(rr[0]) + __uint_as_float(rr[1]); }

__device__ __forceinline__ void select16(const Params& P, LAS unsigned char* lds, int b, int q0, int mrow0, int wave, int lane) {
    const unsigned char* qkv = P.ws + WS_QKV;
    const f16* QI = (const f16*)(qkv + O_QI); const f16* KI = (const f16*)(qkv + O_KI); const float* WI = (const float*)(qkv + O_WI);
    LAS float* sc = (LAS float*)(lds + OFF_SC);
    LAS unsigned long long* msk = (LAS unsigned long long*)(lds + OFF_MSK);
    const int tok0 = b * SEQ + q0, r = lane & 31, h = lane >> 5;
    {
        const int rb = wave & 3, par = wave >> 2;
        f16x8 qf[4];
        { const f16* qp = QI + (size_t)(tok0 + 4 * rb + (r >> 3)) * 512 + (r & 7) * 64 + 8 * h;
#pragma unroll
          for (int s = 0; s < 4; ++s) qf[s] = *(const f16x8*)(qp + 16 * s); }
        float wq[4][4];
#pragma unroll
        for (int qq = 0; qq < 4; ++qq) { const f32x4 w4 = *(const f32x4*)(WI + (size_t)(tok0 + 4 * rb + qq) * 8 + 4 * h);
#pragma unroll
            for (int i = 0; i < 4; ++i) wq[qq][i] = w4[i]; }
        const int nkt = (q0 + 4 * rb + 3) / 32 + 1;
        for (int kt = par; kt < nkt; kt += 2) {
            const f16* kp = KI + (size_t)(b * SEQ + 32 * kt + r) * 64 + 8 * h;
            f16x8 kf[4];
#pragma unroll
            for (int s = 0; s < 4; ++s) kf[s] = *(const f16x8*)(kp + 16 * s);
            f32x16 acc = {};
#pragma unroll
            for (int s = 0; s < 4; ++s) acc = __builtin_amdgcn_mfma_f32_32x32x16_f16(qf[s], kf[s], acc, 0, 0, 0);
            float tot[4];
#pragma unroll
            for (int qq = 0; qq < 4; ++qq) { float pt = 0.f;
#pragma unroll
                for (int i = 0; i < 4; ++i) pt += wq[qq][i] * fmaxf(acc[4 * qq + i], 0.f);
                tot[qq] = swap_sum(pt) + 0.0f; }
            LAS float* scp = sc + (4 * rb) * 2048 + 32 * kt + r;
            if (h == 0) { scp[0] = tot[0]; scp[2048] = tot[1]; } else { scp[2 * 2048] = tot[2]; scp[3 * 2048] = tot[3]; }
        }
    }
    __syncthreads();
    for (int qq2 = 0; qq2 < 2; ++qq2) {
        const int qi = 2 * wave + qq2, t = q0 + qi;
        LAS unsigned long long* mrow = msk + (mrow0 + qi) * 32;
        if (t < TOPK) {
            if (lane < 32) { const int lo = lane * 64; unsigned long long w = 0ull;
                if (lo + 63 <= t) w = ~0ull; else if (lo <= t) w = (1ull << (t - lo + 1)) - 1ull;
                mrow[lane] = w; }
            continue;
        }
        const LAS float* srow = sc + qi * 2048;
        unsigned u[32];
#pragma unroll
        for (int i = 0; i < 32; ++i) { const int s = i * 64 + lane; unsigned v = 0u;
            if (s <= t) { const unsigned bits = __float_as_uint(srow[s]); v = (bits & 0x80000000u) ? ~bits : (bits | 0x80000000u); }
            u[i] = v; }
        unsigned T = 0u;
        for (int bit = 31; bit >= 0; --bit) {
            const unsigned cand = T | (1u << bit); int cnt = 0;
#pragma unroll
            for (int i = 0; i < 32; ++i) cnt += (u[i] >= cand) ? 1 : 0;
            cnt = wave_sum_i(cnt);
            if (cnt >= TOPK) { T = cand; if (cnt == TOPK) break; }
        }
        int cgt = 0;
#pragma unroll
        for (int i = 0; i < 32; ++i) cgt += (u[i] > T) ? 1 : 0;
        cgt = wave_sum_i(cgt);
        const int need = TOPK - cgt; int run = 0;
        const unsigned long long lt = (lane == 0) ? 0ull : ((~0ull) >> (64 - lane));
#pragma unroll
        for (int i = 0; i < 32; ++i) {
            const bool gt = u[i] > T, eq = u[i] == T;
            const unsigned long long eqb = __ballot(eq);
            const int pre = run + __popcll(eqb & lt);
            const unsigned long long w = __ballot(gt || (eq && pre < need));
            run += __popcll(eqb);
            if (lane == 0) mrow[i] = w;
        }
    }
    __syncthreads();
}

template <int MODE>
__device__ __forceinline__ void attn32(const Params& P, int L, LAS unsigned char* lds, int b, int q0, int wave, int lane) {
    const unsigned char* qkv = P.ws + WS_QKV;
    const f16* Q = (const f16*)(qkv + (MODE ? O_QB : O_QA)); const f16* K = (const f16*)(qkv + (MODE ? O_KB : O_KA)); const f16* V = (const f16*)(qkv + (MODE ? O_VB : O_VA));
    f16* Y = (f16*)(qkv + O_Y);
    const int tok0 = b * SEQ + q0, r = lane & 31, h = lane >> 5, head = wave, kvh = wave >> 2, tid = wave * 64 + lane;
    LAS float* wsf = (LAS float*)(lds + OFF_WSF) + wave * 32;
    const LAS unsigned long long* msk = (const LAS unsigned long long*)(lds + OFF_MSK);
    f16x8 qf[4];
    { const f16* qp = Q + (size_t)(tok0 + r) * 512 + head * 64 + 8 * h;
#pragma unroll
      for (int s = 0; s < 4; ++s) qf[s] = *(const f16x8*)(qp + 16 * s); }
    const int kt1 = (q0 + 31) / 64, kt0 = MODE ? 0 : ((q0 - 127 > 0 ? q0 - 127 : 0) / 64);
    float m = MODE ? NEG : P.sinks[L * 8 + head] * LOG2E, lsum = (MODE == 0 && h == 0) ? 1.0f : 0.f;
    f32x16 o0 = {}, o1 = {};
    const int row0 = tid >> 4, part = tid & 15;
    const int ldso = (part >> 3) * KV_HEAD + row0 * RS + (part & 7) * 16;
    const f16* kg = K + (size_t)(b * SEQ + row0) * 128 + part * 8; const f16* vg = V + (size_t)(b * SEQ + row0) * 128 + part * 8;
    u32x4 kr0, kr1, vr0, vr1;
#define MIX_LOAD(kt) do { const size_t go = (size_t)(kt) * 64 * 128; kr0 = *(const u32x4*)(kg + go); kr1 = *(const u32x4*)(kg + go + 32 * 128); vr0 = *(const u32x4*)(vg + go); vr1 = *(const u32x4*)(vg + go + 32 * 128); } while (0)
#define MIX_STORE(st) do { LAS unsigned char* sb = lds + OFF_KV + (st) * KV_STAGE + ldso; *(LAS u32x4*)sb = kr0; *(LAS u32x4*)(sb + 32 * RS) = kr1; *(LAS u32x4*)(sb + 2 * KV_HEAD) = vr0; *(LAS u32x4*)(sb + 2 * KV_HEAD + 32 * RS) = vr1; } while (0)
    MIX_LOAD(kt0); MIX_STORE(0);
    __syncthreads();
    const int trq = (lane & 15) >> 2, trp = lane & 3, trc = (lane >> 4) & 1;
    for (int kt = kt0; kt <= kt1; ++kt) {
        const int cur = (kt - kt0) & 1;
        if (kt < kt1) MIX_LOAD(kt + 1);
        const LAS unsigned char* kb_ = lds + OFF_KV + cur * KV_STAGE + kvh * KV_HEAD; const LAS unsigned char* vb_ = kb_ + 2 * KV_HEAD;
        f32x16 p0 = {}, p1 = {};
#pragma unroll
        for (int s = 0; s < 4; ++s) {
            const f16x8 k0 = *(const LAS f16x8*)(kb_ + r * RS + (16 * s + 8 * h) * 2), k1 = *(const LAS f16x8*)(kb_ + (32 + r) * RS + (16 * s + 8 * h) * 2);
            p0 = __builtin_amdgcn_mfma_f32_32x32x16_f16(k0, qf[s], p0, 0, 0, 0); p1 = __builtin_amdgcn_mfma_f32_32x32x16_f16(k1, qf[s], p1, 0, 0, 0);
        }
        unsigned long long w;
        if (MODE) w = msk[r * 32 + kt];
        else { const int t = q0 + r; int lo = t - 127 - 64 * kt, hi = t - 64 * kt;
            if (hi < 0 || lo > 63) w = 0ull; else { lo = lo < 0 ? 0 : lo; hi = hi > 63 ? 63 : hi; w = ((~0ull) << lo) & ((~0ull) >> (63 - hi)); } }
        const unsigned w0 = (unsigned)w >> (4 * h), w1 = (unsigned)(w >> 32) >> (4 * h);
        float mt = NEG;
#pragma unroll
        for (int g = 0; g < 16; ++g) { const int c = (g & 3) + 8 * (g >> 2);
            mt = ((w0 >> c) & 1u) ? fmaxf(mt, p0[g]) : mt; mt = ((w1 >> c) & 1u) ? fmaxf(mt, p1[g]) : mt; }
        mt = swap_max(mt);
        const float mn = fmaxf(m, mt), alpha = __builtin_amdgcn_exp2f(m - mn); m = mn;
        float ps = 0.f;
#pragma unroll
        for (int g = 0; g < 16; ++g) { const int c = (g & 3) + 8 * (g >> 2);
            p0[g] = ((w0 >> c) & 1u) ? __builtin_amdgcn_exp2f(p0[g] - mn) : 0.f; p1[g] = ((w1 >> c) & 1u) ? __builtin_amdgcn_exp2f(p1[g] - mn) : 0.f; ps += p0[g] + p1[g]; }
        lsum = lsum * alpha + ps;
        if (h == 0) wsf[r] = alpha;
#pragma unroll
        for (int g4 = 0; g4 < 4; ++g4) { const f32x4 a4 = *(const LAS f32x4*)(wsf + 8 * g4 + 4 * h);
#pragma unroll
            for (int i = 0; i < 4; ++i) { o0[4 * g4 + i] *= a4[i]; o1[4 * g4 + i] *= a4[i]; } }
#pragma unroll
        for (int kb = 0; kb < 2; ++kb)
#pragma unroll
            for (int s2 = 0; s2 < 2; ++s2) {
                f16x8 pa;
#pragma unroll
                for (int j = 0; j < 8; ++j) pa[j] = (f16)(kb ? p1[8 * s2 + j] : p0[8 * s2 + j]);
                const LAS unsigned char* vrow = vb_ + (32 * kb + 16 * s2 + 4 * h + trq) * RS + (16 * trc + 4 * trp) * 2;
#pragma unroll
                for (int db = 0; db < 2; ++db) {
                    const s16x4 lo4 = __builtin_amdgcn_ds_read_tr16_b64_v4i16((LAS s16x4*)(vrow + db * 64));
                    const s16x4 hi4 = __builtin_amdgcn_ds_read_tr16_b64_v4i16((LAS s16x4*)(vrow + db * 64 + 8 * RS));
                    const f16x8 vf = __builtin_bit_cast(f16x8, __builtin_shufflevector(lo4, hi4, 0, 1, 2, 3, 4, 5, 6, 7));
                    if (db == 0) o0 = __builtin_amdgcn_mfma_f32_32x32x16_f16(pa, vf, o0, 0, 0, 0); else o1 = __builtin_amdgcn_mfma_f32_32x32x16_f16(pa, vf, o1, 0, 0, 0);
                }
            }
        if (kt < kt1) MIX_STORE(cur ^ 1);
        __syncthreads();
    }
#undef MIX_LOAD
#undef MIX_STORE
    { const float lt = swap_sum(lsum); if (h == 0) wsf[r] = 1.0f / lt; }
    LAS float* stg = (LAS float*)(lds + OFF_KV);
#pragma unroll
    for (int g4 = 0; g4 < 4; ++g4) { const f32x4 a4 = *(const LAS f32x4*)(wsf + 8 * g4 + 4 * h);
#pragma unroll
        for (int i = 0; i < 4; ++i) { const int q = 8 * g4 + 4 * h + i; stg[q * STG_LD + head * 64 + r] = o0[4 * g4 + i] * a4[i]; stg[q * STG_LD + head * 64 + 32 + r] = o1[4 * g4 + i] * a4[i]; } }
    __syncthreads();
#pragma unroll
    for (int qq = 0; qq < 4; ++qq) { const int q = 4 * wave + qq;
        const f32x4 v0 = *(const LAS f32x4*)(stg + q * STG_LD + lane * 8), v1 = *(const LAS f32x4*)(stg + q * STG_LD + lane * 8 + 4);
        float ss = (v0[0] * v0[0] + v0[1] * v0[1]) + (v0[2] * v0[2] + v0[3] * v0[3]) + (v1[0] * v1[0] + v1[1] * v1[1]) + (v1[2] * v1[2] + v1[3] * v1[3]);
        ss = wave_sum(ss);
        const float rr = 1.0f / sqrtf(ss * (1.0f / 512.0f) + 1e-6f);
        f16x8 o; o[0] = (f16)(v0[0] * rr); o[1] = (f16)(v0[1] * rr); o[2] = (f16)(v0[2] * rr); o[3] = (f16)(v0[3] * rr); o[4] = (f16)(v1[0] * rr); o[5] = (f16)(v1[1] * rr); o[6] = (f16)(v1[2] * rr); o[7] = (f16)(v1[3] * rr);
        *(f16x8*)(Y + (size_t)(tok0 + q) * DM + MODE * 512 + lane * 8) = o; }
    __syncthreads();
}

__device__ __forceinline__ void phase_mixer(const Params& P, int L, LAS unsigned char* lds, const int wave_s) {
    const int lane = TIDX(wave_s) & 63, wave = wave_s;
    for (int c = blockIdx.x; c < 256; c += gridDim.x) {
        const int b = c >> 5, qa = c & 31;
        for (int half = 0; half < 2; ++half) {
            const int q0 = 32 * (half ? 63 - qa : qa);
            select16(P, lds, b, q0, 0, wave, lane);
            select16(P, lds, b, q0 + 16, 16, wave, lane);
            attn32<0>(P, L, lds, b, q0, wave, lane);
            attn32<1>(P, L, lds, b, q0, wave, lane);
        }
    }
}
}

__device__ __forceinline__ void phase_ln(const Params& P, const float* g, const float* bta, const float* mod_next  , const int wave_s) {
    const int lane = TIDX(wave_s) & 63, wave = wave_s; f16* H = (f16*)(P.ws + WS_H);
    for (int row = blockIdx.x * 8 + wave; row < MTOK; row += gridDim.x * 8) {
        float* xr = P.out + (size_t)row * DM; const int b = row / SEQ;
        f32x4 v[4]; float s = 0.f;
#pragma unroll
        for (int j = 0; j < 4; ++j) { v[j] = *(const f32x4*)(xr + j * 256 + lane * 4); s += (v[j][0] + v[j][1]) + (v[j][2] + v[j][3]); }
        const float mean = wave_sum(s) * (1.0f / DM); float s2 = 0.f;
#pragma unroll
        for (int j = 0; j < 4; ++j) { v[j] = v[j] - mean; s2 += (v[j][0] * v[j][0] + v[j][1] * v[j][1]) + (v[j][2] * v[j][2] + v[j][3] * v[j][3]); }
        const float rstd = 1.0f / sqrtf(wave_sum(s2) * (1.0f / DM) + 1e-5f);
#pragma unroll
        for (int j = 0; j < 4; ++j) { const int col = j * 256 + lane * 4;
            const f32x4 gg = *(const f32x4*)(g + col), bb = *(const f32x4*)(bta + col);
            const f32x4 xo = v[j] * rstd * gg + bb;
            *(f32x4*)(xr + col) = xo;
            if (mod_next) { const f32x4 sh = *(const f32x4*)(mod_next + (size_t)b * 6 * DM + col), sc = *(const f32x4*)(mod_next + (size_t)b * 6 * DM + DM + col);
                *(f16x4*)(H + (size_t)row * DM + col) = cvt4(xo * (sc + 1.0f) + sh); } }
    }
}

template <int L, int SUB>
__device__ __forceinline__ void layer_phase(const Params& P, LAS unsigned char* lds, const int wave_s) {
    const int G = gridDim.x;
    unsigned char* ws = P.ws; unsigned char* qkv = ws + WS_QKV;
    unsigned char* wb = ws + WS_W + (size_t)L * W_LAYER;
    const float* modl = (const float*)(ws + WS_MOD) + (size_t)L * BATCH * 6 * DM;
    if constexpr (SUB == 0) {
        pg8::Gemm g{(const h16_t*)(ws + WS_H), (const h16_t*)(wb + W_IN), MTOK, NINP, DM}; pg8::StaticOrder S; S.init(MTOK, NINP, G, (int)blockIdx.x);
        EpiRope E{(f16*)(qkv + O_QA), (f16*)(qkv + O_KA), (f16*)(qkv + O_VA), (f16*)(qkv + O_QB), (f16*)(qkv + O_KB), (f16*)(qkv + O_VB), (f16*)(qkv + O_QI), (f16*)(qkv + O_KI), (float*)(qkv + O_WI), (const float*)(ws + WS_ROPE)};
        pg8::gemm_phase<EpiRope, pg8::StaticOrder, true, true>(lds, g, S, E, wave_s);
    } else if constexpr (SUB == 1) {
#if MK_NAIVE_ATTN
        phase_swa_naive(P, L, wave_s); phase_select_naive(P, lds, wave_s);
#else
        mix::phase_mixer(P, L, lds, wave_s);
#endif
    } else if constexpr (SUB == 2) {
#if MK_NAIVE_ATTN
        phase_dsa_naive(P, wave_s);
#endif
    }
    else if constexpr (SUB == 3) {
        pg8::Gemm g{(const h16_t*)(qkv + O_Y), (const h16_t*)(wb + W_O), MTOK, DM, DM}; pg8::StaticOrder S; S.init(MTOK, DM, G, (int)blockIdx.x);
        EpiResid E{L == 0 ? P.x : P.out, P.out, modl + 2 * DM};
        pg8::gemm_phase<EpiResid, pg8::StaticOrder, true, true>(lds, g, S, E, wave_s);
    } else if constexpr (SUB == 4) phase_ln(P, P.ln1_g + L * DM, P.ln1_b + L * DM, modl + 3 * DM, wave_s);
    else if constexpr (SUB == 5) {
        pg8::Gemm g{(const h16_t*)(ws + WS_H), (const h16_t*)(wb + W_GU), MTOK, NGU, DM}; pg8::StaticOrder S; S.init(MTOK, NGU, G, (int)blockIdx.x);
        EpiSwiglu E{(f16*)qkv};
        pg8::gemm_phase<EpiSwiglu, pg8::StaticOrder, true, true>(lds, g, S, E, wave_s);
    } else if constexpr (SUB == 6) {
        pg8::Gemm g{(const h16_t*)qkv, (const h16_t*)(wb + W_D), MTOK, DM, DFF}; pg8::StaticOrder S; S.init(MTOK, DM, G, (int)blockIdx.x);
        EpiResid E{P.out, P.out, modl + 5 * DM};
        pg8::gemm_phase<EpiResid, pg8::StaticOrder, true, true>(lds, g, S, E, wave_s);
    } else phase_ln(P, P.ln2_g + L * DM, P.ln2_b + L * DM, (L + 1 < DEPTH) ? (modl + BATCH * 6 * DM) : nullptr, wave_s);
}

__global__ void __launch_bounds__(512, 2) mk_fwd(Params P) {
    extern __shared__ __attribute__((aligned(16))) unsigned char lds_raw[];
    LAS unsigned char* lds = (LAS unsigned char*)lds_raw;
    const int lo = P.ph_lo, hi = P.ph_hi, use_cg = P.use_cg;
    const int wave_s = __builtin_amdgcn_readfirstlane(threadIdx.x >> 6);
    typedef const __attribute__((address_space(4))) Params* CParams;
#if defined(__HIP_DEVICE_COMPILE__)
#define FRESH() CParams pp_ = (CParams)__builtin_amdgcn_kernarg_segment_ptr(); asm volatile("" : "+s"(pp_)); const Params Pl = *pp_;
#else
#define FRESH() const Params Pl = P;
#endif
#define IN(k) (lo <= (k) && (k) < hi)
#define SEAM(k) do { if (IN((k) + 1)) { if (use_cg) cg::this_grid().sync(); } __syncthreads(); } while (0)
#define LPH(L, SUB) if (IN(2 + 8 * (L) + (SUB))) { { FRESH(); layer_phase<L, SUB>(Pl, lds, wave_s); } SEAM(2 + 8 * (L) + (SUB)); }
    if (IN(0)) { { FRESH(); phase_prep(Pl, lds, wave_s); } SEAM(0); }
    if (IN(1)) { { FRESH(); phase_h0(Pl, wave_s); } SEAM(1); }
    LPH(0, 0) LPH(0, 1) LPH(0, 2) LPH(0, 3) LPH(0, 4) LPH(0, 5) LPH(0, 6) LPH(0, 7)
    LPH(1, 0) LPH(1, 1) LPH(1, 2) LPH(1, 3) LPH(1, 4) LPH(1, 5) LPH(1, 6) LPH(1, 7)
#undef IN
#undef SEAM
#undef LPH
}

#ifndef MK_CHECK
#define MK_CHECK 0
#define MK_CHECK_LAYER 0
#define MK_CHECK_BASE 0
#endif
#if MK_CHECK
__device__ __forceinline__ void flag_max(float* f, float err) { if (!(err == err)) err = 1e30f; atomicMax((int*)f, __float_as_int(err)); }
__device__ __forceinline__ int samp_tok(int j) { return (int)(((long)j * 5231 + 1777) % MTOK); }
__global__ void chk_mod(Params P, float* flags) {
    const int j = blockIdx.x * blockDim.x + threadIdx.x; if (j >= 512) return;
    const int l = j & 1, b = (j >> 1) & 7, n = ((j >> 4) * 197 + 13) % (6 * DM);
    float ref = P.b_ada[l * 6 * DM + n];
    for (int k = 0; k < DM; ++k) { const float v = P.c[b * DM + k]; ref += (v / (1.0f + expf(-v))) * P.w_ada[((size_t)l * DM + k) * 6 * DM + n]; }
    const float got = ((const float*)(P.ws + WS_MOD))[((size_t)l * BATCH + b) * 6 * DM + n];
    flag_max(flags + 0, fabsf(ref - got) / (fabsf(ref) + 0.02f));
}
__global__ void chk_inproj(Params P, float* flags, int L) {
    const int j = blockIdx.x * blockDim.x + threadIdx.x; if (j >= 32 * 34 * 2) return;
    const int tok = samp_tok(j / 68), r = j % 68, hb = r >> 1, dd = (r & 1) ? 21 : 3, b = tok / SEQ;
    const float* mod = (const float*)(P.ws + WS_MOD) + ((size_t)L * BATCH + b) * 6 * DM;
    const float* w = P.w_in + (size_t)L * DM * NIN;
    const float* xr = (L == 0 ? P.x : P.out) + (size_t)tok * DM;
    const unsigned char* qkv = P.ws + WS_QKV;
    if (hb == 33) {
        const int c = 2112 + (dd == 3 ? 1 : 6); float a = 0.f;
        for (int k = 0; k < DM; ++k) { const float h = (float)(f16)(xr[k] * (1.0f + mod[DM + k]) + mod[k]); a += h * (float)(f16)w[(size_t)k * NIN + c]; }
        const float got = ((const float*)(qkv + O_WI))[(size_t)tok * 8 + (c - 2112)];
        flag_max(flags + 1, fabsf(a - got) / (fabsf(a) + 0.05f)); return;
    }
    const int c = hb * 64 + dd; float a1 = 0.f, a2 = 0.f;
    for (int k = 0; k < DM; ++k) { const float h = (float)(f16)(xr[k] * (1.0f + mod[DM + k]) + mod[k]); a1 += h * (float)(f16)w[(size_t)k * NIN + c]; a2 += h * (float)(f16)w[(size_t)k * NIN + c + 32]; }
    const f16* dst; int pitch, col; bool rope = true; float sc = 1.f;
    if (hb < 8) { dst = (const f16*)(qkv + O_QA); pitch = 512; col = hb * 64; sc = QSCALE; }
    else if (hb < 10) { dst = (const f16*)(qkv + O_KA); pitch = 128; col = (hb - 8) * 64; }
    else if (hb < 12) { dst = (const f16*)(qkv + O_VA); pitch = 128; col = (hb - 10) * 64; rope = false; }
    else if (hb < 20) { dst = (const f16*)(qkv + O_QB); pitch = 512; col = (hb - 12) * 64; sc = QSCALE; }
    else if (hb < 22) { dst = (const f16*)(qkv + O_KB); pitch = 128; col = (hb - 20) * 64; }
    else if (hb < 24) { dst = (const f16*)(qkv + O_VB); pitch = 128; col = (hb - 22) * 64; rope = false; }
    else if (hb < 32) { dst = (const f16*)(qkv + O_QI); pitch = 512; col = (hb - 24) * 64; }
    else { dst = (const f16*)(qkv + O_KI); pitch = 64; col = 0; }
    float o1 = a1, o2 = a2;
    if (rope) { const float inv = powf(10000.0f, -(float)dd / 32.0f); const float ang = (float)P.pos[tok] * inv; const float cs = (float)cos((double)ang), sn = (float)sin((double)ang);
        o1 = (a1 * cs - a2 * sn) * sc; o2 = (a2 * cs + a1 * sn) * sc; }
    const float g1 = (float)dst[(size_t)tok * pitch + col + dd], g2 = (float)dst[(size_t)tok * pitch + col + dd + 32];
    flag_max(flags + 1, fabsf(o1 - g1) / (fabsf(o1) + 0.05f)); flag_max(flags + 1, fabsf(o2 - g2) / (fabsf(o2) + 0.05f));
}
__global__ void chk_swa(Params P, float* flags, int L) {
    __shared__ float sc[8][128]; __shared__ float red[512]; __shared__ float den[8];
    const int tok = samp_tok(blockIdx.x * 7 + 3), t = tok % SEQ, b = tok / SEQ, tid = threadIdx.x, h = tid >> 6, d = tid & 63, kvh = h >> 2;
    const unsigned char* qkv = P.ws + WS_QKV;
    const f16* QA = (const f16*)(qkv + O_QA); const f16* KA = (const f16*)(qkv + O_KA); const f16* VA = (const f16*)(qkv + O_VA); const f16* Y = (const f16*)(qkv + O_Y);
    const int s0 = t - 127 < 0 ? 0 : t - 127, nk = t - s0 + 1;
    for (int i = d; i < nk; i += 64) { float a = 0.f; for (int e = 0; e < 64; ++e) a += (float)QA[(size_t)tok * 512 + h * 64 + e] * (float)KA[((size_t)(b * SEQ + s0 + i)) * 128 + kvh * 64 + e]; sc[h][i] = a; }
    __syncthreads();
    if (d == 0) { float m = P.sinks[L * 8 + h] * LOG2E; for (int i = 0; i < nk; ++i) m = fmaxf(m, sc[h][i]); float dn = exp2f(P.sinks[L * 8 + h] * LOG2E - m); for (int i = 0; i < nk; ++i) { const float p = exp2f(sc[h][i] - m); sc[h][i] = p; dn += p; } den[h] = dn; }
    __syncthreads();
    float o = 0.f; for (int i = 0; i < nk; ++i) o += sc[h][i] * (float)VA[((size_t)(b * SEQ + s0 + i)) * 128 + kvh * 64 + d];
    o /= den[h]; red[tid] = o * o; __syncthreads();
    for (int st = 256; st > 0; st >>= 1) { if (tid < st) red[tid] += red[tid + st]; __syncthreads(); }
    const float ref = o / sqrtf(red[0] / 512.0f + 1e-6f), got = (float)Y[(size_t)tok * DM + h * 64 + d];
    flag_max(flags + 2, fabsf(ref - got) / (fabsf(ref) + 0.1f));
}
__global__ void chk_dsa(Params P, float* flags) {
    __shared__ float ssc[2048]; __shared__ unsigned char sel[2048]; __shared__ float red[512]; __shared__ float pm[8], dn[8]; __shared__ float diff[512];
    const int tok = samp_tok(blockIdx.x * 61 + 5), t = tok % SEQ, b = tok / SEQ, tid = threadIdx.x, h = tid >> 6, d = tid & 63, kvh = h >> 2;
    const unsigned char* qkv = P.ws + WS_QKV;
    const f16* QB = (const f16*)(qkv + O_QB); const f16* KB = (const f16*)(qkv + O_KB); const f16* VB = (const f16*)(qkv + O_VB); const f16* Y = (const f16*)(qkv + O_Y);
    const f16* QI = (const f16*)(qkv + O_QI); const f16* KI = (const f16*)(qkv + O_KI); const float* WI = (const float*)(qkv + O_WI);
    for (int s = tid; s <= t; s += 512) { float tot = 0.f;
        for (int hh = 0; hh < 8; ++hh) { float a = 0.f; for (int e = 0; e < 64; ++e) a += (float)QI[(size_t)tok * 512 + hh * 64 + e] * (float)KI[((size_t)(b * SEQ + s)) * 64 + e]; tot += WI[(size_t)tok * 8 + hh] * fmaxf(a, 0.f); }
        ssc[s] = tot + 0.0f; }
    __syncthreads();
    for (int s = tid; s <= t; s += 512) { int rank = 0; const float v = ssc[s]; for (int i = 0; i <= t; ++i) { const float w = ssc[i]; rank += (w > v || (w == v && i < s)) ? 1 : 0; } sel[s] = rank < TOPK ? 1 : 0; }
    __syncthreads();
    float o = 0.f;
    for (int hh = 0; hh < 8; ++hh) {
        __syncthreads();
        for (int s = tid; s <= t; s += 512) { float a = -INFINITY; if (sel[s]) { a = 0.f; for (int e = 0; e < 64; ++e) a += (float)QB[(size_t)tok * 512 + hh * 64 + e] * (float)KB[((size_t)(b * SEQ + s)) * 128 + (hh >> 2) * 64 + e]; } ssc[s] = a; }
        __syncthreads();
        if (tid == 0) { float m = -INFINITY; for (int s = 0; s <= t; ++s) m = fmaxf(m, ssc[s]); float dd = 0.f; for (int s = 0; s <= t; ++s) dd += exp2f(ssc[s] - m); pm[hh] = m; dn[hh] = dd; }
        __syncthreads();
        if (h == hh) { float acc = 0.f; for (int s = 0; s <= t; ++s) if (sel[s]) acc += exp2f(ssc[s] - pm[hh]) * (float)VB[((size_t)(b * SEQ + s)) * 128 + kvh * 64 + d]; o = acc / dn[hh]; }
    }
    __syncthreads();
    red[tid] = o * o; __syncthreads();
    for (int st = 256; st > 0; st >>= 1) { if (tid < st) red[tid] += red[tid + st]; __syncthreads(); }
    const float ref = o / sqrtf(red[0] / 512.0f + 1e-6f), got = (float)Y[(size_t)tok * DM + 512 + h * 64 + d];
    __syncthreads();
    diff[tid] = (ref - got) * (ref - got); __syncthreads();
    for (int st = 256; st > 0; st >>= 1) { if (tid < st) diff[tid] += diff[tid + st]; __syncthreads(); }
    if (tid == 0) flag_max(flags + 3, sqrtf(diff[0] / 512.0f));
}
__global__ void chk_resid(Params P, float* flags, int L, int which  , const float* xin_saved) {
    const int j = blockIdx.x * blockDim.x + threadIdx.x; if (j >= 1024) return;
    const int tok = samp_tok(j >> 4), n = ((j & 15) * 67 + 5) % DM, b = tok / SEQ;
    const float* mod = (const float*)(P.ws + WS_MOD) + ((size_t)L * BATCH + b) * 6 * DM;
    float a = 0.f;
    if (which == 0) { const f16* Y = (const f16*)(P.ws + WS_QKV + O_Y); const float* w = P.w_o + (size_t)L * DM * DM;
        for (int k = 0; k < DM; ++k) { const float g = k < 512 ? P.g_a[L * 512 + k] : P.g_b[L * 512 + k - 512]; a += (float)Y[(size_t)tok * DM + k] * (float)(f16)(g * w[(size_t)k * DM + n]); } }
    else { const f16* A = (const f16*)(P.ws + WS_QKV); const float* w = P.w_down + (size_t)L * DFF * DM;
        for (int k = 0; k < DFF; ++k) a += (float)A[(size_t)tok * DFF + k] * (float)(f16)w[(size_t)k * DM + n]; }
    const float ref = ALPHA * xin_saved[(j >> 4) * DM + n] + (1.0f + mod[(which ? 5 : 2) * DM + n]) * a, got = P.out[(size_t)tok * DM + n];
    flag_max(flags + (which ? 6 : 4), fabsf(ref - got) / (fabsf(ref) + 0.1f));
}
__global__ void chk_save_rows(const float* src, float* dst) {
    const int r = blockIdx.x; const int tok = samp_tok(r); for (int i = threadIdx.x; i < DM; i += blockDim.x) dst[r * DM + i] = src[(size_t)tok * DM + i];
}
__global__ void chk_act(Params P, float* flags, int L) {
    const int j = blockIdx.x * blockDim.x + threadIdx.x; if (j >= 1024) return;
    const int tok = samp_tok(j >> 4), f = ((j & 15) * 173 + 9) % DFF;
    const f16* H = (const f16*)(P.ws + WS_H); const float* wg = P.w_gate + (size_t)L * DM * DFF; const float* wu = P.w_up + (size_t)L * DM * DFF;
    float g = 0.f, u = 0.f; for (int k = 0; k < DM; ++k) { const float h = (float)H[(size_t)tok * DM + k]; g += h * (float)(f16)wg[(size_t)k * DFF + f]; u += h * (float)(f16)wu[(size_t)k * DFF + f]; }
    const float ref = g / (1.0f + expf(-g)) * u, got = (float)((const f16*)(P.ws + WS_QKV))[(size_t)tok * DFF + f];
    flag_max(flags + 5, fabsf(ref - got) / (fabsf(ref) + 0.05f));
}
__global__ void chk_ln(Params P, float* flags, const float* pre_saved, const float* g, const float* bta, const float* mod_next_l  , int shidx) {
    __shared__ float red[256];
    const int r = blockIdx.x, tok = samp_tok(r), b = tok / SEQ, tid = threadIdx.x;
    float s = 0.f; for (int i = tid; i < DM; i += 256) s += pre_saved[r * DM + i]; red[tid] = s; __syncthreads();
    for (int st = 128; st > 0; st >>= 1) { if (tid < st) red[tid] += red[tid + st]; __syncthreads(); }
    const float mean = red[0] / DM; __syncthreads();
    float q = 0.f; for (int i = tid; i < DM; i += 256) { const float dlt = pre_saved[r * DM + i] - mean; q += dlt * dlt; } red[tid] = q; __syncthreads();
    for (int st = 128; st > 0; st >>= 1) { if (tid < st) red[tid] += red[tid + st]; __syncthreads(); }
    const float rstd = 1.0f / sqrtf(red[0] / DM + 1e-5f);
    for (int i = tid; i < DM; i += 256) { const float ref = (pre_saved[r * DM + i] - mean) * rstd * g[i] + bta[i]; const float got = P.out[(size_t)tok * DM + i];
        flag_max(flags + 7, fabsf(ref - got) / (fabsf(ref) + 0.1f));
        if (mod_next_l) { const float* mb = mod_next_l + (size_t)b * 6 * DM; const float hr = ref * (1.0f + mb[(shidx + 1) * DM + i]) + mb[shidx * DM + i]; const float hg = (float)((const f16*)(P.ws + WS_H))[(size_t)tok * DM + i];
            flag_max(flags + 7, fabsf(hr - hg) / (fabsf(hr) + 0.1f)); } }
}
__global__ void chk_encode(float* out, const float* flags, int base, float t0, float t1, float t2, float t3) {
    const float th[4] = {t0, t1, t2, t3}; int z = 0;
    for (int k = 0; k < 4; ++k) if (flags[base + k] > th[k]) z |= (8 >> k);
    for (size_t i = (size_t)blockIdx.x * blockDim.x + threadIdx.x; i < (size_t)MTOK * DM; i += (size_t)gridDim.x * blockDim.x) if ((int)(i & 15) < z) out[i] = 0.f;
}
#endif

#ifndef MK_ONE_LAUNCH
#define MK_ONE_LAUNCH 1
#endif
extern "C" void kernel_launch(void* const* d_in, const int* in_sizes, int n_in, void* d_out, int out_size, void* d_ws, size_t ws_size, hipStream_t stream) {
    static int grid = 0;
    if (grid == 0) {
        if (n_in != 17 || out_size != MTOK * DM || ws_size < WS_END) { fprintf(stderr, "kernel_launch: unexpected shapes (n_in %d out %d ws %zu)\n", n_in, out_size, ws_size); grid = -1; return; }
        int dev = 0, cus = 0, per_cu = 0;
        hipGetDevice(&dev); hipDeviceGetAttribute(&cus, hipDeviceAttributeMultiprocessorCount, dev);
        hipFuncSetAttribute((const void*)mk_fwd, hipFuncAttributeMaxDynamicSharedMemorySize, LDS_BYTES);
        hipOccupancyMaxActiveBlocksPerMultiprocessor(&per_cu, (const void*)mk_fwd, 512, LDS_BYTES);
        if (per_cu < 1) { fprintf(stderr, "kernel_launch: occupancy query says %d blocks per CU\n", per_cu); per_cu = 1; }
        (void)hipGetLastError();
        grid = cus;
    }
    if (grid < 0) return;
    Params p{};
    p.x = (const float*)d_in[0]; p.c = (const float*)d_in[1]; p.pos = (const int*)d_in[2]; p.w_ada = (const float*)d_in[3]; p.b_ada = (const float*)d_in[4]; p.w_in = (const float*)d_in[5];
    p.sinks = (const float*)d_in[6]; p.g_a = (const float*)d_in[7]; p.g_b = (const float*)d_in[8]; p.w_o = (const float*)d_in[9]; p.ln1_g = (const float*)d_in[10]; p.ln1_b = (const float*)d_in[11];
    p.w_gate = (const float*)d_in[12]; p.w_up = (const float*)d_in[13]; p.w_down = (const float*)d_in[14]; p.ln2_g = (const float*)d_in[15]; p.ln2_b = (const float*)d_in[16];
    p.out = (float*)d_out; p.ws = (unsigned char*)d_ws;
#if MK_ONE_LAUNCH
    p.ph_lo = 0; p.ph_hi = NPHASE; p.use_cg = 1;
    void* args[] = {&p};
    hipError_t e = hipLaunchCooperativeKernel((const void*)mk_fwd, dim3(grid), dim3(512), args, LDS_BYTES, stream);
    if (e != hipSuccess) fprintf(stderr, "cooperative launch failed: %s (grid %d)\n", hipGetErrorString(e), grid);
#else
#if MK_CHECK
    float* flags = (float*)((char*)d_ws + WS_CTL); float* save0 = (float*)((char*)d_ws + WS_CTL + 4096); float* save1 = save0 + 64 * DM;
    (void)hipMemsetAsync(flags, 0, 4096, stream);
    const int CL = MK_CHECK_LAYER;
#endif
    for (int ph = 0; ph < NPHASE; ++ph) {
        p.ph_lo = ph; p.ph_hi = ph + 1; p.use_cg = 0;
#if MK_CHECK
        const int cl = (ph - 2) >> 3, cs = (ph - 2) & 7;
        if (ph >= 2 && cl == CL && cs == 0 && CL == 0) {}
        if (ph >= 2 && cl == CL && cs == 3) hipLaunchKernelGGL(chk_save_rows, dim3(64), dim3(256), 0, stream, (const float*)(CL == 0 ? p.x : p.out), save0);
        if (ph >= 2 && cl == CL && cs == 6) hipLaunchKernelGGL(chk_save_rows, dim3(64), dim3(256), 0, stream, (const float*)p.out, save0);
#endif
        hipLaunchKernelGGL(mk_fwd, dim3(grid), dim3(512), LDS_BYTES, stream, p);
#if MK_CHECK
        if (ph == 0) hipLaunchKernelGGL(chk_mod, dim3(2), dim3(256), 0, stream, p, flags);
        if (ph >= 2 && cl == CL) {
            if (cs == 0 && CL == 0) hipLaunchKernelGGL(chk_inproj, dim3(9), dim3(256), 0, stream, p, flags, CL);
            if (cs == 1) hipLaunchKernelGGL(chk_swa, dim3(24), dim3(512), 0, stream, p, flags, CL);
            if (cs == 2) hipLaunchKernelGGL(chk_dsa, dim3(24), dim3(512), 0, stream, p, flags);
            if (cs == 3) { hipLaunchKernelGGL(chk_resid, dim3(4), dim3(256), 0, stream, p, flags, CL, 0, (const float*)save0); hipLaunchKernelGGL(chk_save_rows, dim3(64), dim3(256), 0, stream, (const float*)p.out, save1); }
            if (cs == 4) hipLaunchKernelGGL(chk_ln, dim3(64), dim3(256), 0, stream, p, flags, (const float*)save1, p.ln1_g + CL * DM, p.ln1_b + CL * DM, (const float*)((char*)d_ws + WS_MOD) + (size_t)CL * BATCH * 6 * DM, 3);
            if (cs == 5) hipLaunchKernelGGL(chk_act, dim3(4), dim3(256), 0, stream, p, flags, CL);
            if (cs == 6) hipLaunchKernelGGL(chk_resid, dim3(4), dim3(256), 0, stream, p, flags, CL, 1, (const float*)save0);
        }
#endif
    }
#if MK_CHECK
    hipLaunchKernelGGL(chk_encode, dim3(1024), dim3(256), 0, stream, (float*)d_out, (const float*)flags, MK_CHECK_BASE, MK_CHECK_BASE == 0 ? 0.02f : 0.03f, 0.03f, MK_CHECK_BASE == 0 ? 0.05f : 0.03f, MK_CHECK_BASE == 0 ? 0.3f : 0.03f);
#endif
#endif
}
```

```cpp
#include <hip/hip_runtime.h>
#include <hip/hip_cooperative_groups.h>
#include <cstdio>
#include <cstdint>
#include <cmath>
namespace cg = cooperative_groups;

constexpr int BATCH = 8, SEQ = 2048, DM = 1024, DEPTH = 2, MTOK = BATCH * SEQ;
constexpr int HD = 64, DFF = 2816, NIN = 2120, NINP = 2304, NGU = 2 * DFF;
constexpr int TOPK = 256;
constexpr float ALPHA = 1.4142135623730951f;
constexpr float LOG2E = 1.4426950408889634f;
constexpr float QSCALE = 0.125f * LOG2E;

typedef _Float16 f16;
typedef _Float16 f16x2 __attribute__((ext_vector_type(2)));
typedef _Float16 f16x4 __attribute__((ext_vector_type(4)));
typedef _Float16 f16x8 __attribute__((ext_vector_type(8)));
typedef unsigned short h16_t;
typedef short s16x8 __attribute__((ext_vector_type(8)));
typedef float f32x4 __attribute__((ext_vector_type(4)));
typedef float f32x2 __attribute__((ext_vector_type(2)));
typedef unsigned u32x4 __attribute__((ext_vector_type(4)));
typedef unsigned u32x2 __attribute__((ext_vector_type(2)));
#define LAS __attribute__((address_space(3)))
#define TIDX(ws_) ((ws_) * 64 + (int)__builtin_amdgcn_mbcnt_hi(~0u, __builtin_amdgcn_mbcnt_lo(~0u, 0u)))

constexpr size_t MiB = 1u << 20;
constexpr size_t WS_CTL = 0;
constexpr size_t WS_MOD = 1 * MiB;
constexpr size_t WS_ROPE = 2 * MiB;
constexpr size_t WS_W = 6 * MiB;
constexpr size_t W_LAYER = 23 * MiB, W_IN = 0, W_O = (size_t)NINP * DM * 2, W_GU = W_O + (size_t)DM * DM * 2, W_D = W_GU + (size_t)NGU * DM * 2;
constexpr size_t WS_H = 52 * MiB;
constexpr size_t WS_MASK = 84 * MiB;
constexpr size_t WS_QKV = 88 * MiB;
constexpr size_t O_QA = 0, O_KA = O_QA + (size_t)MTOK * 512 * 2, O_VA = O_KA + (size_t)MTOK * 128 * 2, O_QB = O_VA + (size_t)MTOK * 128 * 2,
                 O_KB = O_QB + (size_t)MTOK * 512 * 2, O_VB = O_KB + (size_t)MTOK * 128 * 2, O_QI = O_VB + (size_t)MTOK * 128 * 2,
                 O_KI = O_QI + (size_t)MTOK * 512 * 2, O_WI = O_KI + (size_t)MTOK * 64 * 2, O_Y = O_WI + (size_t)MTOK * 8 * 4, O_END = O_Y + (size_t)MTOK * DM * 2;
constexpr size_t WS_END = WS_QKV + O_END;
static_assert(W_D + (size_t)DM * DFF * 2 <= W_LAYER, "weights per layer");
static_assert(WS_W + DEPTH * W_LAYER <= WS_H, "ws map");
static_assert((size_t)MTOK * DFF * 2 <= O_END, "ACT overlay fits");
static_assert(WS_END <= 256 * MiB, "workspace");

namespace pg8 {
constexpr int BM = 256, BK = 64, HALF = 128, HTB = HALF * BK * 2, STAGE_BYTES = 8 * HTB, NXCD = 8, WGM = 8;
__host__ __device__ __forceinline__ int lds_byte(int r, int c) { const int st = (r >> 4) * 2 + (c >> 5), rr = r & 15, cc = c & 31, ob = rr * 64 + cc * 2; return st * 1024 + (ob ^ (((ob >> 9) & 1) << 5)); }
__host__ __device__ __forceinline__ void stage_rc(int b, int& R, int& C) { const int st = b / 1024, sb = b % 1024, swz = sb ^ (((sb >> 9) & 1) << 5); R = (st >> 1) * 16 + swz / 64; C = (st & 1) * 32 + (swz % 64) / 2; }
__host__ __device__ __forceinline__ int perm32(int rho) { const int n = rho >> 4, i = rho & 15; return 8 * (i >> 2) + 4 * n + (i & 3); }
struct Unit { int pm, pn; };
struct Gemm { const h16_t* A; const h16_t* Bt; int M, N, K; };
struct StaticOrder {
    int nM, nN, nwg, G, c;
    __host__ __device__ void init(int M, int N, int G_, int c_) { nM = M / BM; nN = N / BM; nwg = nM * nN; G = G_; c = c_; }
    __host__ __device__ bool next(int i, Unit& u) const {
        const long L = (long)i * G + c; if (L >= nwg) return false;
        int wgid = (int)L; { const int q = nwg / NXCD, r = nwg % NXCD, xcd = wgid % NXCD, off = wgid / NXCD; wgid = (xcd < r ? xcd * (q + 1) : r * (q + 1) + (xcd - r) * q) + off; }
        const int nig = WGM * nN, gid = wgid / nig, fm = gid * WGM, gsz = (nM - fm) < WGM ? (nM - fm) : WGM;
        u.pm = fm + ((wgid % nig) % gsz); u.pn = (wgid % nig) / gsz; return true;
    }
    __device__ __forceinline__ void a_ready(const Unit&) const {}
    __device__ __forceinline__ void done(const Unit&) const {}
};

template <class Epi, class Sched, bool ALIGN_EPI = false, bool SP2 = false>
__device__ __forceinline__ void gemm_phase(LAS unsigned char* lds, const Gemm g, const Sched& S, const Epi& E, const int wave_s) {
    const int tid = TIDX(wave_s), wid = wave_s, lane = tid & 63, wr = wid >> 2, wc = wid & 3, fr = lane & 15, fq = lane >> 4;
    const int K = g.K, nt = K / BK;
    unsigned voffA[2], voffB[2];
#pragma unroll
    for (int i = 0; i < 2; ++i) { int R, C; stage_rc(tid * 16 + i * 8192, R, C); const int Rb = Epi::PERM ? ((R & ~31) + perm32(R & 31)) : R;
        voffA[i] = (unsigned)(R * K + C) * 2u; voffB[i] = (unsigned)(Rb * K + C) * 2u; }
    const size_t kstep = (size_t)(BK * 2);
    const size_t hstep = (size_t)HALF * K * 2;
    const size_t tstep = 2 * hstep;
    const unsigned ldsw = (unsigned)wid * 1024u;
    const int aoff = lds_byte(wr * 64 + fr, fq * 8), boff = lds_byte(wc * 32 + fr, fq * 8);
#define PG8_SA(b, h) (((b) * 2 + (h)) * HTB)
#define PG8_SB(b, h) ((4 + (b) * 2 + (h)) * HTB)
#define PG8_STAGE(bufoff, gbase, voff) do { _Pragma("unroll") for (int _i = 0; _i < 2; ++_i) \
        __builtin_amdgcn_global_load_lds((const unsigned*)((const char*)(gbase) + (voff)[_i]), (LAS unsigned*)(lds + (bufoff) + ldsw + _i * 8192), 16, 0, 0); } while (0)
#define PG8_LDA(dst, b, h) do { _Pragma("unroll") for (int m = 0; m < 4; ++m) _Pragma("unroll") for (int k = 0; k < 2; ++k) dst[m][k] = *(const LAS s16x8*)(lds + PG8_SA(b, h) + aoff + m * 2048 + k * 1024); } while (0)
#define PG8_LDB(dst, b, h) do { _Pragma("unroll") for (int n = 0; n < 2; ++n) _Pragma("unroll") for (int k = 0; k < 2; ++k) dst[n][k] = *(const LAS s16x8*)(lds + PG8_SB(b, h) + boff + n * 2048 + k * 1024); } while (0)
#define PG8_MMA(ai, bj, At, Bt) do { __builtin_amdgcn_s_setprio(1); _Pragma("unroll") for (int m = 0; m < 4; ++m) _Pragma("unroll") for (int n = 0; n < 2; ++n) _Pragma("unroll") for (int k = 0; k < 2; ++k) \
        acc[ai][bj][m][n] = __builtin_amdgcn_mfma_f32_16x16x32_f16(__builtin_bit_cast(f16x8, Bt[n][k]), __builtin_bit_cast(f16x8, At[m][k]), acc[ai][bj][m][n], 0, 0, 0); __builtin_amdgcn_s_setprio(0); } while (0)
#define PG8_WAIT_V(n) asm volatile("s_waitcnt vmcnt(" #n ")" ::: "memory")
#define PG8_WAIT_L(n) asm volatile("s_waitcnt lgkmcnt(" #n ")" ::: "memory")
#define PG8_BAR __builtin_amdgcn_s_barrier()
#define PG8_SCHED __builtin_amdgcn_sched_barrier(0)
    Unit cur, nxt; int ui = 0;
    if (!S.next(0, cur)) return;
    f32x4 acc[2][2][4][2];
#pragma unroll
    for (int a = 0; a < 2; ++a)
#pragma unroll
        for (int b = 0; b < 2; ++b)
#pragma unroll
            for (int m = 0; m < 4; ++m)
#pragma unroll
                for (int n = 0; n < 2; ++n) acc[a][b][m][n] = (f32x4){0.f, 0.f, 0.f, 0.f};
    s16x8 At[4][2], B0[2][2], B1[2][2];
    const char* cA = (const char*)g.A + (size_t)cur.pm * tstep; const char* cB = (const char*)g.Bt + (size_t)cur.pn * tstep;
    S.a_ready(cur);
    if constexpr (SP2) {
        PG8_STAGE(PG8_SB(0, 0), cB, voffB); PG8_STAGE(PG8_SB(0, 1), cB + hstep, voffB); PG8_STAGE(PG8_SA(0, 0), cA, voffA); PG8_STAGE(PG8_SA(0, 1), cA + hstep, voffA);
        if (wr == 1) PG8_BAR;
        PG8_WAIT_V(2); PG8_BAR;
        PG8_STAGE(PG8_SB(1, 0), cB + kstep, voffB); PG8_STAGE(PG8_SA(1, 0), cA + kstep, voffA); PG8_STAGE(PG8_SB(1, 1), cB + hstep + kstep, voffB);
        PG8_WAIT_V(6); PG8_BAR;
    } else {
        PG8_STAGE(PG8_SB(0, 0), cB, voffB); PG8_STAGE(PG8_SA(0, 0), cA, voffA); PG8_STAGE(PG8_SB(0, 1), cB + hstep, voffB); PG8_STAGE(PG8_SA(0, 1), cA + hstep, voffA);
        if (wr == 1) PG8_BAR;
        PG8_WAIT_V(4); PG8_BAR;
        PG8_STAGE(PG8_SB(1, 0), cB + kstep, voffB); PG8_STAGE(PG8_SA(1, 0), cA + kstep, voffA); PG8_STAGE(PG8_SB(1, 1), cB + hstep + kstep, voffB);
        PG8_WAIT_V(6); PG8_BAR;
    }
    for (;;) {
        const bool has_next = S.next(ui + 1, nxt);
        const char* nA = has_next ? (const char*)g.A + (size_t)nxt.pm * tstep : cA; const char* nB = has_next ? (const char*)g.Bt + (size_t)nxt.pn * tstep : cB;
        for (int t = 0; t < nt; t += 2) {
            const bool last = (t == nt - 2);
            const char* a1 = cA + (size_t)(t + 1) * kstep;
            const char* a2 = last ? nA : cA + (size_t)(t + 2) * kstep; const char* b2 = last ? nB : cB + (size_t)(t + 2) * kstep;
            const char* a3 = a2 + kstep; const char* b3 = b2 + kstep;
            if (last && has_next) S.a_ready(nxt);
            if constexpr (SP2) {
            PG8_LDB(B0, 0, 0); PG8_LDB(B1, 0, 1); PG8_SCHED; PG8_LDA(At, 0, 0); PG8_STAGE(PG8_SA(1, 1), a1 + hstep, voffA);
            PG8_WAIT_V(8); PG8_WAIT_L(0); PG8_BAR; PG8_MMA(0, 0, At, B0); PG8_MMA(0, 1, At, B1); PG8_BAR; PG8_SCHED;
            PG8_LDA(At, 0, 1); PG8_STAGE(PG8_SB(0, 0), b2, voffB); PG8_STAGE(PG8_SB(0, 1), b2 + hstep, voffB); PG8_STAGE(PG8_SA(0, 0), a2, voffA);
            PG8_WAIT_V(8); PG8_WAIT_L(0); PG8_BAR; PG8_MMA(1, 0, At, B0); PG8_MMA(1, 1, At, B1); PG8_BAR; PG8_SCHED;
            PG8_LDB(B0, 1, 0); PG8_LDB(B1, 1, 1); PG8_SCHED; PG8_LDA(At, 1, 0); PG8_STAGE(PG8_SA(0, 1), a2 + hstep, voffA);
            PG8_WAIT_V(8); PG8_WAIT_L(0); PG8_BAR; PG8_MMA(0, 0, At, B0); PG8_MMA(0, 1, At, B1); PG8_BAR; PG8_SCHED;
            PG8_LDA(At, 1, 1); PG8_STAGE(PG8_SB(1, 0), b3, voffB); PG8_STAGE(PG8_SB(1, 1), b3 + hstep, voffB); PG8_STAGE(PG8_SA(1, 0), a3, voffA);
            PG8_WAIT_V(8); PG8_WAIT_L(0); PG8_BAR; PG8_MMA(1, 0, At, B0); PG8_MMA(1, 1, At, B1); PG8_BAR; PG8_SCHED;
            } else {
            PG8_LDB(B0, 0, 0); PG8_SCHED; PG8_LDA(At, 0, 0); PG8_STAGE(PG8_SA(1, 1), a1 + hstep, voffA);
            PG8_WAIT_L(8); PG8_BAR; PG8_WAIT_L(0); PG8_MMA(0, 0, At, B0); PG8_BAR; PG8_SCHED;
            PG8_LDB(B1, 0, 1); PG8_STAGE(PG8_SB(0, 0), b2, voffB);
            PG8_BAR; PG8_WAIT_L(0); PG8_MMA(0, 1, At, B1); PG8_BAR;
            PG8_LDA(At, 0, 1); PG8_STAGE(PG8_SA(0, 0), a2, voffA);
            PG8_BAR; PG8_WAIT_L(0); PG8_MMA(1, 0, At, B0); PG8_BAR; PG8_SCHED;
            PG8_STAGE(PG8_SB(0, 1), b2 + hstep, voffB);
            PG8_WAIT_V(6); PG8_BAR; PG8_MMA(1, 1, At, B1); PG8_BAR;
            PG8_LDB(B0, 1, 0); PG8_SCHED; PG8_LDA(At, 1, 0); PG8_STAGE(PG8_SA(0, 1), a2 + hstep, voffA);
            PG8_WAIT_L(8); PG8_BAR; PG8_WAIT_L(0); PG8_MMA(0, 0, At, B0); PG8_BAR; PG8_SCHED;
            PG8_LDB(B1, 1, 1); PG8_STAGE(PG8_SB(1, 0), b3, voffB);
            PG8_BAR; PG8_WAIT_L(0); PG8_MMA(0, 1, At, B1); PG8_BAR;
            PG8_LDA(At, 1, 1); PG8_STAGE(PG8_SA(1, 0), a3, voffA);
            PG8_BAR; PG8_WAIT_L(0); PG8_MMA(1, 0, At, B0); PG8_BAR; PG8_SCHED;
            PG8_STAGE(PG8_SB(1, 1), b3 + hstep, voffB);
            PG8_WAIT_V(6); PG8_BAR; PG8_MMA(1, 1, At, B1); PG8_BAR;
            }
        }
        if constexpr (ALIGN_EPI) { if (wr == 0) PG8_BAR; }
        if constexpr (!Epi::AFTER_DRAIN) { E(acc, cur, wr, wc, fr, fq); S.done(cur); }
        if (!has_next) break;
#pragma unroll
        for (int a = 0; a < 2; ++a)
#pragma unroll
            for (int b = 0; b < 2; ++b)
#pragma unroll
                for (int m = 0; m < 4; ++m)
#pragma unroll
                    for (int n = 0; n < 2; ++n) acc[a][b][m][n] = (f32x4){0.f, 0.f, 0.f, 0.f};
        cur = nxt; cA = nA; cB = nB; ++ui;
        if constexpr (ALIGN_EPI) { if (wr == 1) PG8_BAR; }
    }
    PG8_WAIT_V(0);
    if constexpr (!ALIGN_EPI) { if (wr == 0) PG8_BAR; }
    PG8_BAR;
    if constexpr (Epi::AFTER_DRAIN) { E.fused(acc, cur, wr, wc, fr, fq, lds, wid, lane); S.done(cur); }
#undef PG8_SA
#undef PG8_SB
#undef PG8_STAGE
#undef PG8_LDA
#undef PG8_LDB
#undef PG8_MMA
#undef PG8_WAIT_V
#undef PG8_WAIT_L
#undef PG8_BAR
#undef PG8_SCHED
}
}

__device__ __forceinline__ f16x4 cvt4(f32x4 v) { return (f16x4){(f16)v[0], (f16)v[1], (f16)v[2], (f16)v[3]}; }

struct EpiRope {
    static constexpr bool PERM = false, AFTER_DRAIN = false;
    f16 *qa, *ka, *va, *qb, *kb, *vb, *qi, *ki; float* wi; const float* cs;
    __device__ __forceinline__ void operator()(const f32x4 (&acc)[2][2][4][2], const pg8::Unit& u, int wr, int wc, int fr, int fq) const {
        const int grp = wc & 1, d0 = 16 * grp + 4 * fq;
#pragma unroll
        for (int ai = 0; ai < 2; ++ai)
#pragma unroll
            for (int m = 0; m < 4; ++m) {
                const int row = u.pm * 256 + ai * 128 + wr * 64 + m * 16 + fr;
                const f32x4* cp = (const f32x4*)(cs + ((size_t)row * 32 + d0) * 2);
                const f32x4 c01 = cp[0], c23 = cp[1];
                const float co[4] = {c01[0], c01[2], c23[0], c23[2]}, si[4] = {c01[1], c01[3], c23[1], c23[3]};
#pragma unroll
                for (int bj = 0; bj < 2; ++bj) {
                    const int cb = u.pn * 256 + bj * 128 + wc * 32, hb = cb >> 6;
                    const f32x4 a0 = acc[ai][bj][m][0], a1 = acc[ai][bj][m][1];
                    if (hb >= 34) continue;
                    if (hb == 33) { if (grp == 0 && fq < 2) *(f32x4*)(wi + (size_t)row * 8 + 4 * fq) = a0; continue; }
                    f16* dst; int pitch, col; bool rope = true; float sc = 1.f;
                    if (hb < 8) { dst = qa; pitch = 512; col = hb * 64; sc = QSCALE; }
                    else if (hb < 10) { dst = ka; pitch = 128; col = (hb - 8) * 64; }
                    else if (hb < 12) { dst = va; pitch = 128; col = (hb - 10) * 64; rope = false; }
                    else if (hb < 20) { dst = qb; pitch = 512; col = (hb - 12) * 64; sc = QSCALE; }
                    else if (hb < 22) { dst = kb; pitch = 128; col = (hb - 20) * 64; }
                    else if (hb < 24) { dst = vb; pitch = 128; col = (hb - 22) * 64; rope = false; }
                    else if (hb < 32) { dst = qi; pitch = 512; col = (hb - 24) * 64; }
                    else { dst = ki; pitch = 64; col = 0; }
                    f32x4 o0, o1;
                    if (rope) {
#pragma unroll
                        for (int i = 0; i < 4; ++i) { o0[i] = (a0[i] * co[i] - a1[i] * si[i]) * sc; o1[i] = (a1[i] * co[i] + a0[i] * si[i]) * sc; }
                    } else { o0 = a0; o1 = a1; }
                    f16* p = dst + (size_t)row * pitch + col + d0;
                    *(f16x4*)p = cvt4(o0); *(f16x4*)(p + 32) = cvt4(o1);
                }
            }
    }
};
struct EpiResid {
    static constexpr bool PERM = false, AFTER_DRAIN = false;
    const float* xin; float* out; const float* gate;
    __device__ __forceinline__ void operator()(const f32x4 (&acc)[2][2][4][2], const pg8::Unit& u, int wr, int wc, int fr, int fq) const {
        const int b = (u.pm * 256) / SEQ;
        f32x4 gt[2][2];
#pragma unroll
        for (int bj = 0; bj < 2; ++bj)
#pragma unroll
            for (int n = 0; n < 2; ++n) { gt[bj][n] = *(const f32x4*)(gate + (size_t)b * 6 * DM + u.pn * 256 + bj * 128 + wc * 32 + n * 16 + 4 * fq); gt[bj][n] = gt[bj][n] + 1.0f; }
#pragma unroll
        for (int ai = 0; ai < 2; ++ai)
#pragma unroll
            for (int m = 0; m < 4; ++m) {
                const int row = u.pm * 256 + ai * 128 + wr * 64 + m * 16 + fr;
#pragma unroll
                for (int bj = 0; bj < 2; ++bj)
#pragma unroll
                    for (int n = 0; n < 2; ++n) {
                        const size_t off = (size_t)row * DM + u.pn * 256 + bj * 128 + wc * 32 + n * 16 + 4 * fq;
                        const f32x4 xv = *(const f32x4*)(xin + off);
                        *(f32x4*)(out + off) = xv * ALPHA + gt[bj][n] * acc[ai][bj][m][n];
                    }
            }
    }
};
struct EpiSwiglu {
    static constexpr bool PERM = false, AFTER_DRAIN = false;
    f16* act;
    __device__ __forceinline__ void operator()(const f32x4 (&acc)[2][2][4][2], const pg8::Unit& u, int wr, int wc, int fr, int fq) const {
#pragma unroll
        for (int ai = 0; ai < 2; ++ai)
#pragma unroll
            for (int m = 0; m < 4; ++m) {
                const int row = u.pm * 256 + ai * 128 + wr * 64 + m * 16 + fr;
#pragma unroll
                for (int bj = 0; bj < 2; ++bj) {
                    const int f0 = (u.pn * 256 + bj * 128 + wc * 32) / 2 + 4 * fq;
                    const f32x4 g = acc[ai][bj][m][0], up = acc[ai][bj][m][1]; f32x4 o;
#pragma unroll
                    for (int i = 0; i < 4; ++i) { const float e = __builtin_amdgcn_exp2f(-g[i] * LOG2E); o[i] = g[i] * __builtin_amdgcn_rcpf(1.0f + e) * up[i]; }
                    *(f16x4*)(act + (size_t)row * DFF + f0) = cvt4(o);
                }
            }
    }
};

struct Params {
    const float* x; const float* c; const int* pos; const float* w_ada; const float* b_ada; const float* w_in; const float* sinks; const float* g_a; const float* g_b; const float* w_o;
    const float* ln1_g; const float* ln1_b; const float* w_gate; const float* w_up; const float* w_down; const float* ln2_g; const float* ln2_b;
    float* out; unsigned char* ws;
    int ph_lo, ph_hi, use_cg, pad;
};
constexpr int NPHASE = 2 + 8 * DEPTH;
#ifndef MK_BARRIER
#define MK_BARRIER 2
#endif
#if MK_BARRIER == 1
#define CG_SYNC() cg::this_grid().sync()
#else
#define CG_SYNC() do {} while (0)
#endif
#ifndef MK_NAIVE_ATTN
#define MK_NAIVE_ATTN 0
#endif
constexpr int LDS_BYTES = 147456;

__device__ __forceinline__ int wave_sum_i(int v) {
#pragma unroll
    for (int o = 1; o < 64; o <<= 1) v += __shfl_xor(v, o);
    return v;
}
__device__ __forceinline__ float wave_sum(float v) {
#pragma unroll
    for (int o = 1; o < 64; o <<= 1) v += __shfl_xor(v, o);
    return v;
}

template <class Map>
__device__ __forceinline__ void transpose_items(const Map& map, int K, int nphys, f16* WT, LAS float* scr, int gw, int NGW, int lane) {
    const int nkb = K / 64, nitems = (nphys / 32) * nkb;
    for (int it = gw; it < nitems; it += NGW) {
        const int pg = it / nkb, kb = it % nkb, k0 = kb * 64;
        const float* src = map.src(pg * 32 + (lane & 31)); const size_t ld = (size_t)Map::LD;
#pragma unroll 8
        for (int i = 0; i < 32; ++i) { const int kk = 2 * i + (lane >> 5); const float v = src ? src[(size_t)(k0 + kk) * ld] : 0.f; scr[kk * 33 + (lane & 31)] = v; }
        asm volatile("s_waitcnt lgkmcnt(0)" ::: "memory");
        const int c = lane & 7;
#pragma unroll
        for (int j = 0; j < 4; ++j) { const int n = (lane >> 3) + 8 * j; const LAS float* s = scr + (8 * c) * 33 + n;
            f16x8 o;
#pragma unroll
            for (int e = 0; e < 8; ++e) o[e] = (f16)s[e * 33];
            *(f16x8*)(WT + (size_t)(pg * 32 + n) * K + k0 + 8 * c) = o; }
        asm volatile("s_waitcnt lgkmcnt(0)" ::: "memory");
    }
}
struct MapIn { const float* w; static constexpr int LD = NIN;
    __device__ __forceinline__ const float* src(int p) const {
        if (p < 2112) { const int hb = p >> 6, within = p & 63, grp = within >> 5, half = (within & 31) >> 4, off = within & 15; return w + hb * 64 + 16 * grp + off + 32 * half; }
        return (p < NIN) ? (w + p) : nullptr; } };
struct MapGU { const float* wg; const float* wu; static constexpr int LD = DFF;
    __device__ __forceinline__ const float* src(int p) const { const int blk = p >> 5, within = p & 31, which = within >> 4, off = within & 15; const long long dlt = (const char*)wu - (const char*)wg; return (const float*)((const char*)wg + (long long)which * dlt) + 16 * blk + off; } };
struct MapD { const float* w; static constexpr int LD = DM;
    __device__ __forceinline__ const float* src(int p) const { return w + p; } };

__device__ __forceinline__ void sincos_acc(float ang, float& c, float& s) {
    const double x = (double)ang;
    const double n = rint(x * 0.63661977236758134308);
    const double r = fma(-n, 1.57079632679489661923, x) - n * 6.123233995736766e-17;
    const double r2 = r * r;
    double sp = -7.6471637318198164759e-13; sp = fma(sp, r2, 1.6059043836821614599e-10); sp = fma(sp, r2, -2.5052108385441718775e-8); sp = fma(sp, r2, 2.7557319223985890653e-6);
    sp = fma(sp, r2, -1.9841269841269841270e-4); sp = fma(sp, r2, 8.3333333333333333333e-3); sp = fma(sp, r2, -1.6666666666666666667e-1); sp = fma(sp * r2, r, r);
    double cp = 4.7794773323873852974e-14; cp = fma(cp, r2, -1.1470745597729724714e-11); cp = fma(cp, r2, 2.0876756987868098979e-9); cp = fma(cp, r2, -2.7557319223985890653e-7);
    cp = fma(cp, r2, 2.4801587301587301587e-5); cp = fma(cp, r2, -1.3888888888888888889e-3); cp = fma(cp, r2, 4.1666666666666666667e-2); cp = fma(cp, r2, -0.5); cp = fma(cp, r2, 1.0);
    const int q = ((int)n) & 3;
    const double sv = (q & 1) ? cp : sp, cv = (q & 1) ? sp : cp;
    s = (float)((q & 2) ? -sv : sv); c = (float)(((q + 1) & 2) ? -cv : cv);
}

__device__ __forceinline__ void phase_prep(const Params& P, LAS unsigned char* lds, const int wave_s) {
    const int tid = TIDX(wave_s), lane = tid & 63, wave = wave_s, G = gridDim.x;
    {
        LAS float* cact = (LAS float*)lds;
        LAS float* red = (LAS float*)(lds + 32768);
        for (int i = tid; i < BATCH * DM; i += 512) { const float v = P.c[i]; cact[i] = v / (1.0f + __expf(-v)); }
        __syncthreads();
        const int nitems = DEPTH * (6 * DM / 32);
        for (int it = blockIdx.x; it < nitems; it += G) {
            const int l = it / (6 * DM / 32), n0 = (it % (6 * DM / 32)) * 32, col = lane & 31, slice = wave * 2 + (lane >> 5);
            const float* w = P.w_ada + (size_t)l * DM * 6 * DM + n0 + col;
            float a[8] = {0.f, 0.f, 0.f, 0.f, 0.f, 0.f, 0.f, 0.f};
#pragma unroll 8
            for (int kk = 0; kk < 64; ++kk) { const int k = slice * 64 + kk; const float wv = w[(size_t)k * 6 * DM];
#pragma unroll
                for (int b = 0; b < 8; ++b) a[b] += cact[b * DM + k] * wv; }
#pragma unroll
            for (int b = 0; b < 8; ++b) red[(slice * 8 + b) * 32 + col] = a[b];
            __syncthreads();
            if (tid < 256) { const int b = tid >> 5, cc = tid & 31; float s = P.b_ada[(size_t)l * 6 * DM + n0 + cc];
#pragma unroll
                for (int sl = 0; sl < 16; ++sl) s += red[(sl * 8 + b) * 32 + cc];
                ((float*)(P.ws + WS_MOD))[((size_t)l * BATCH + b) * 6 * DM + n0 + cc] = s; }
            __syncthreads();
        }
    }
    {
        float* cs = (float*)(P.ws + WS_ROPE);
        for (int i = blockIdx.x * 512 + tid; i < MTOK * 32; i += G * 512) { const int tok = i >> 5, j = i & 31;
            const float ang = (float)P.pos[tok] * (float)exp2((double)j * (-13.287712379549449 / 32.0)); float c, s; sincos_acc(ang, c, s); cs[2 * (size_t)i] = c; cs[2 * (size_t)i + 1] = s; }
    }
    {
        __syncthreads();
        LAS float* scr = (LAS float*)(lds + wave * 16384);
        const int gw = blockIdx.x * 8 + wave, NGW = G * 8;
        for (int l = 0; l < DEPTH; ++l) {
            unsigned char* wb = P.ws + WS_W + l * W_LAYER;
            transpose_items(MapIn{P.w_in + (size_t)l * DM * NIN}, DM, NINP, (f16*)(wb + W_IN), scr, gw, NGW, lane);
            {
                const float* wo = P.w_o + (size_t)l * DM * DM; const float* ga = P.g_a + l * 512; const float* gb = P.g_b + l * 512;
                const int nkb = DM / 64, nitems = (DM / 32) * nkb;
                for (int it = gw; it < nitems; it += NGW) {
                    const int pg = it / nkb, kb = it % nkb, k0 = kb * 64; const float* ksc = (k0 < 512) ? (ga + k0) : (gb + (k0 - 512));
                    const float* src = wo + pg * 32 + (lane & 31);
#pragma unroll 8
                    for (int i = 0; i < 32; ++i) { const int kk = 2 * i + (lane >> 5); scr[kk * 33 + (lane & 31)] = src[(size_t)(k0 + kk) * DM] * ksc[kk]; }
                    asm volatile("s_waitcnt lgkmcnt(0)" ::: "memory");
                    const int c = lane & 7;
#pragma unroll
                    for (int j = 0; j < 4; ++j) { const int n = (lane >> 3) + 8 * j; const LAS float* s = scr + (8 * c) * 33 + n; f16x8 o;
#pragma unroll
                        for (int e = 0; e < 8; ++e) o[e] = (f16)s[e * 33];
                        *(f16x8*)((f16*)(wb + W_O) + (size_t)(pg * 32 + n) * DM + k0 + 8 * c) = o; }
                    asm volatile("s_waitcnt lgkmcnt(0)" ::: "memory");
                }
            }
            transpose_items(MapGU{P.w_gate + (size_t)l * DM * DFF, P.w_up + (size_t)l * DM * DFF}, DM, NGU, (f16*)(wb + W_GU), scr, gw, NGW, lane);
            transpose_items(MapD{P.w_down + (size_t)l * DFF * DM}, DFF, DM, (f16*)(wb + W_D), scr, gw, NGW, lane);
        }
    }
}

__device__ __forceinline__ void phase_h0(const Params& P, const int wave_s) {
    const float* mod = (const float*)(P.ws + WS_MOD); f16* H = (f16*)(P.ws + WS_H);
    const size_t n8 = (size_t)MTOK * DM / 8;
    for (size_t i = (size_t)blockIdx.x * 512 + TIDX(wave_s); i < n8; i += (size_t)gridDim.x * 512) {
        const size_t e = i * 8; const int row = (int)(e / DM), col = (int)(e % DM), b = row / SEQ;
        const f32x4 x0 = *(const f32x4*)(P.x + e), x1 = *(const f32x4*)(P.x + e + 4);
        const float* mb = mod + (size_t)b * 6 * DM;
        const f32x4 sh0 = *(const f32x4*)(mb + col), sh1 = *(const f32x4*)(mb + col + 4), sc0 = *(const f32x4*)(mb + DM + col), sc1 = *(const f32x4*)(mb + DM + col + 4);
        const f32x4 h0 = x0 * (sc0 + 1.0f) + sh0, h1 = x1 * (sc1 + 1.0f) + sh1;
        f16x8 o = {(f16)h0[0], (f16)h0[1], (f16)h0[2], (f16)h0[3], (f16)h1[0], (f16)h1[1], (f16)h1[2], (f16)h1[3]};
        *(f16x8*)(H + e) = o;
    }
}

__device__ __forceinline__ float dot64(const u32x4 (&q)[8], const u32x4 (&k)[8]) {
    float s = 0.f;
#pragma unroll
    for (int i = 0; i < 8; ++i)
#pragma unroll
        for (int j = 0; j < 4; ++j) { const unsigned qa_ = q[i][j], kb_ = k[i][j]; s = __builtin_amdgcn_fdot2(__builtin_bit_cast(f16x2, qa_), __builtin_bit_cast(f16x2, kb_), s, false); }
    return s;
}
__device__ __forceinline__ void phase_swa_naive(const Params& P, int l, const int wave_s) {
    const unsigned char* qkv = P.ws + WS_QKV;
    const f16* QA = (const f16*)(qkv + O_QA); const f16* KA = (const f16*)(qkv + O_KA); const f16* VA = (const f16*)(qkv + O_VA); f16* Y = (f16*)(qkv + O_Y);
    for (int idx = blockIdx.x * 512 + TIDX(wave_s); idx < MTOK * 8; idx += gridDim.x * 512) {
        const int tok = idx >> 3, h = idx & 7, kvh = h >> 2, t = tok % SEQ, b = tok / SEQ;
        u32x4 q[8];
#pragma unroll
        for (int i = 0; i < 8; ++i) q[i] = *(const u32x4*)(QA + (size_t)tok * 512 + h * 64 + i * 8);
        float m = P.sinks[l * 8 + h] * LOG2E, lsum = 1.0f;
        float o[64];
#pragma unroll
        for (int d = 0; d < 64; ++d) o[d] = 0.f;
        const int s0 = t - 127 < 0 ? 0 : t - 127;
        for (int s = s0; s <= t; ++s) {
            const size_t kr = ((size_t)(b * SEQ + s)) * 128 + kvh * 64;
            u32x4 k[8];
#pragma unroll
            for (int i = 0; i < 8; ++i) k[i] = *(const u32x4*)(KA + kr + i * 8);
            const float sc = dot64(q, k);
            const float mn = fmaxf(m, sc), al = __builtin_amdgcn_exp2f(m - mn), p = __builtin_amdgcn_exp2f(sc - mn);
            lsum = lsum * al + p; m = mn;
#pragma unroll
            for (int i = 0; i < 8; ++i) { const f16x8 v = *(const f16x8*)(VA + kr + i * 8);
#pragma unroll
                for (int e = 0; e < 8; ++e) o[i * 8 + e] = o[i * 8 + e] * al + p * (float)v[e]; }
        }
        const float il = 1.0f / lsum; float ss = 0.f;
#pragma unroll
        for (int d = 0; d < 64; ++d) { o[d] *= il; ss += o[d] * o[d]; }
        ss += __shfl_xor(ss, 1); ss += __shfl_xor(ss, 2); ss += __shfl_xor(ss, 4);
        const float r = 1.0f / sqrtf(ss * (1.0f / 512.0f) + 1e-6f);
#pragma unroll
        for (int i = 0; i < 8; ++i) { f16x8 w;
#pragma unroll
            for (int e = 0; e < 8; ++e) w[e] = (f16)(o[i * 8 + e] * r);
            *(f16x8*)(Y + (size_t)tok * DM + h * 64 + i * 8) = w; }
    }
}
__device__ __forceinline__ void phase_select_naive(const Params& P, LAS unsigned char* lds, const int wave_s) {
    const unsigned char* qkv = P.ws + WS_QKV;
    const f16* QI = (const f16*)(qkv + O_QI); const f16* KI = (const f16*)(qkv + O_KI); const float* WI = (const float*)(qkv + O_WI);
    unsigned long long* MASK = (unsigned long long*)(P.ws + WS_MASK);
    const int tid = TIDX(wave_s), lane = tid & 63, wave = wave_s;
    LAS unsigned* qs = (LAS unsigned*)(lds + wave * 9216);
    LAS float* ssc = (LAS float*)(lds + wave * 9216 + 1024);
    for (int tok = blockIdx.x * 8 + wave; tok < MTOK; tok += gridDim.x * 8) {
        const int t = tok % SEQ, b = tok / SEQ;
        unsigned long long* mrow = MASK + (size_t)tok * 32;
        if (t < TOPK) {
            if (lane < 32) { const int lo = lane * 64; unsigned long long w = 0ull;
                if (lo + 63 <= t) w = ~0ull; else if (lo <= t) w = (1ull << (t - lo + 1)) - 1ull;
                mrow[lane] = w; }
            continue;
        }
        { const u32x4 v = *(const u32x4*)(QI + (size_t)tok * 512 + lane * 8); *(LAS u32x4*)(qs + lane * 4) = v; }
        float wv[8];
#pragma unroll
        for (int h = 0; h < 8; ++h) wv[h] = WI[(size_t)tok * 8 + h];
        asm volatile("s_waitcnt lgkmcnt(0)" ::: "memory");
        const int nch = t / 64 + 1;
        for (int c = 0; c < nch; ++c) {
            const int s = c * 64 + lane;
            u32x4 k[8];
#pragma unroll
            for (int i = 0; i < 8; ++i) k[i] = *(const u32x4*)(KI + ((size_t)(b * SEQ + s)) * 64 + i * 8);
            float sc = 0.f;
#pragma unroll
            for (int h = 0; h < 8; ++h) { float d = 0.f;
#pragma unroll
                for (int i = 0; i < 8; ++i) { const u32x4 qv = *(const LAS u32x4*)(qs + h * 32 + i * 4);
#pragma unroll
                    for (int j = 0; j < 4; ++j) { const unsigned qa_ = qv[j], kb_ = k[i][j]; d = __builtin_amdgcn_fdot2(__builtin_bit_cast(f16x2, qa_), __builtin_bit_cast(f16x2, kb_), d, false); } }
                sc += wv[h] * fmaxf(d, 0.f); }
            ssc[s] = sc;
        }
        asm volatile("s_waitcnt lgkmcnt(0)" ::: "memory");
        unsigned u[32];
#pragma unroll
        for (int i = 0; i < 32; ++i) { const int s = i * 64 + lane; unsigned v = 0u;
            if (s <= t) { const unsigned bits = __float_as_uint(ssc[s] + 0.0f); v = (bits & 0x80000000u) ? ~bits : (bits | 0x80000000u); }
            u[i] = v; }
        unsigned T = 0u;
        for (int bit = 31; bit >= 0; --bit) {
            const unsigned cand = T | (1u << bit); int cnt = 0;
#pragma unroll
            for (int i = 0; i < 32; ++i) cnt += (u[i] >= cand) ? 1 : 0;
            cnt = wave_sum_i(cnt);
            if (cnt >= TOPK) T = cand;
        }
        int cgt = 0;
#pragma unroll
        for (int i = 0; i < 32; ++i) cgt += (u[i] > T) ? 1 : 0;
        cgt = wave_sum_i(cgt);
        const int need = TOPK - cgt; int run = 0;
        const unsigned long long lt = (lane == 0) ? 0ull : ((~0ull) >> (64 - lane));
#pragma unroll
        for (int i = 0; i < 32; ++i) {
            const bool gt = u[i] > T, eq = u[i] == T;
            const unsigned long long eqb = __ballot(eq);
            const int pre = run + __popcll(eqb & lt);
            const unsigned long long w = __ballot(gt || (eq && pre < need));
            run += __popcll(eqb);
            if (lane == 0) mrow[i] = w;
        }
    }
}
__device__ __forceinline__ void phase_dsa_naive(const Params& P, const int wave_s) {
    const unsigned char* qkv = P.ws + WS_QKV;
    const f16* QB = (const f16*)(qkv + O_QB); const f16* KB = (const f16*)(qkv + O_KB); const f16* VB = (const f16*)(qkv + O_VB); f16* Y = (f16*)(qkv + O_Y);
    const unsigned long long* MASK = (const unsigned long long*)(P.ws + WS_MASK);
    for (int idx = blockIdx.x * 512 + TIDX(wave_s); idx < MTOK * 8; idx += gridDim.x * 512) {
        const int tok = idx >> 3, h = idx & 7, kvh = h >> 2, t = tok % SEQ, b = tok / SEQ;
        u32x4 q[8];
#pragma unroll
        for (int i = 0; i < 8; ++i) q[i] = *(const u32x4*)(QB + (size_t)tok * 512 + h * 64 + i * 8);
        float m = -1e30f, lsum = 0.f;
        float o[64];
#pragma unroll
        for (int d = 0; d < 64; ++d) o[d] = 0.f;
        const int nw = t / 64 + 1;
        for (int wi_ = 0; wi_ < nw; ++wi_) {
            unsigned long long bits = MASK[(size_t)tok * 32 + wi_];
            while (bits) {
                const int j = __builtin_ctzll(bits); bits &= bits - 1ull;
                const int s = wi_ * 64 + j;
                const size_t kr = ((size_t)(b * SEQ + s)) * 128 + kvh * 64;
                u32x4 k[8];
#pragma unroll
                for (int i = 0; i < 8; ++i) k[i] = *(const u32x4*)(KB + kr + i * 8);
                const float sc = dot64(q, k);
                const float mn = fmaxf(m, sc), al = __builtin_amdgcn_exp2f(m - mn), p = __builtin_amdgcn_exp2f(sc - mn);
                lsum = lsum * al + p; m = mn;
#pragma unroll
                for (int i = 0; i < 8; ++i) { const f16x8 v = *(const f16x8*)(VB + kr + i * 8);
#pragma unroll
                    for (int e = 0; e < 8; ++e) o[i * 8 + e] = o[i * 8 + e] * al + p * (float)v[e]; }
            }
        }
        const float il = 1.0f / lsum; float ss = 0.f;
#pragma unroll
        for (int d = 0; d < 64; ++d) { o[d] *= il; ss += o[d] * o[d]; }
        ss += __shfl_xor(ss, 1); ss += __shfl_xor(ss, 2); ss += __shfl_xor(ss, 4);
        const float r = 1.0f / sqrtf(ss * (1.0f / 512.0f) + 1e-6f);
#pragma unroll
        for (int i = 0; i < 8; ++i) { f16x8 w;
#pragma unroll
            for (int e = 0; e < 8; ++e) w[e] = (f16)(o[i * 8 + e] * r);
            *(f16x8*)(Y + (size_t)tok * DM + 512 + h * 64 + i * 8) = w; }
    }
}

namespace mix {
typedef float f32x16 __attribute__((ext_vector_type(16)));
typedef short s16x4 __attribute__((ext_vector_type(4)));
constexpr int RS = 144;
constexpr int KV_HEAD = 64 * RS;
constexpr int KV_STAGE = 4 * KV_HEAD;
constexpr int OFF_KV = 0;
constexpr int STG_LD = 516;
constexpr int OFF_SC = 0;
constexpr int OFF_MSK = 131072;
constexpr int OFF_WSF = 139264;
static_assert(OFF_WSF + 1024 <= LDS_BYTES && 2 * KV_STAGE <= OFF_MSK && 32 * STG_LD * 4 <= OFF_MSK, "mixer LDS map");
constexpr float NEG = -1e30f;
__device__ __forceinline__ int crow(int reg, int h) { return (reg & 3) + 8 * (reg >> 2) + 4 * h; }
__device__ __forceinline__ float swap_max(float v) { auto rr = __builtin_amdgcn_permlane32_swap(__float_as_uint(v), __float_as_uint(v), false, false); return fmaxf(__uint_as_float(rr[0]), __uint_as_float(rr[1])); }
__device__ __forceinline__ float swap_sum(float v) { auto rr = __builtin_amdgcn_permlane32_swap(__float_as_uint(v), __float_as_uint(v), false, false); return __uint_as_float(rr[0]) + __uint_as_float(rr[1]); }

__device__ __forceinline__ void select16(const Params& P, LAS unsigned char* lds, int b, int q0, int mrow0, int wave, int lane) {
    const unsigned char* qkv = P.ws + WS_QKV;
    const f16* QI = (const f16*)(qkv + O_QI); const f16* KI = (const f16*)(qkv + O_KI); const float* WI = (const float*)(qkv + O_WI);
    LAS float* sc = (LAS float*)(lds + OFF_SC);
    LAS unsigned long long* msk = (LAS unsigned long long*)(lds + OFF_MSK);
    const int tok0 = b * SEQ + q0, r = lane & 31, h = lane >> 5;
    {
        const int rb = wave & 3, par = wave >> 2;
        f16x8 qf[4];
        { const f16* qp = QI + (size_t)(tok0 + 4 * rb + (r >> 3)) * 512 + (r & 7) * 64 + 8 * h;
#pragma unroll
          for (int s = 0; s < 4; ++s) qf[s] = *(const f16x8*)(qp + 16 * s); }
        float wq[4][4];
#pragma unroll
        for (int qq = 0; qq < 4; ++qq) { const f32x4 w4 = *(const f32x4*)(WI + (size_t)(tok0 + 4 * rb + qq) * 8 + 4 * h);
#pragma unroll
            for (int i = 0; i < 4; ++i) wq[qq][i] = w4[i]; }
        const int nkt = (q0 + 4 * rb + 3) / 32 + 1;
        for (int kt = par; kt < nkt; kt += 2) {
            const f16* kp = KI + (size_t)(b * SEQ + 32 * kt + r) * 64 + 8 * h;
            f16x8 kf[4];
#pragma unroll
            for (int s = 0; s < 4; ++s) kf[s] = *(const f16x8*)(kp + 16 * s);
            f32x16 acc = {};
#pragma unroll
            for (int s = 0; s < 4; ++s) acc = __builtin_amdgcn_mfma_f32_32x32x16_f16(qf[s], kf[s], acc, 0, 0, 0);
            float tot[4];
#pragma unroll
            for (int qq = 0; qq < 4; ++qq) { float pt = 0.f;
#pragma unroll
                for (int i = 0; i < 4; ++i) pt += wq[qq][i] * fmaxf(acc[4 * qq + i], 0.f);
                tot[qq] = swap_sum(pt) + 0.0f; }
            LAS float* scp = sc + (4 * rb) * 2048 + 32 * kt + r;
            if (h == 0) { scp[0] = tot[0]; scp[2048] = tot[1]; } else { scp[2 * 2048] = tot[2]; scp[3 * 2048] = tot[3]; }
        }
    }
    __syncthreads();
    for (int qq2 = 0; qq2 < 2; ++qq2) {
        const int qi = 2 * wave + qq2, t = q0 + qi;
        LAS unsigned long long* mrow = msk + (mrow0 + qi) * 32;
        if (t < TOPK) {
            if (lane < 32) { const int lo = lane * 64; unsigned long long w = 0ull;
                if (lo + 63 <= t) w = ~0ull; else if (lo <= t) w = (1ull << (t - lo + 1)) - 1ull;
                mrow[lane] = w; }
            continue;
        }
        const LAS float* srow = sc + qi * 2048;
        unsigned u[32];
#pragma unroll
        for (int i = 0; i < 32; ++i) { const int s = i * 64 + lane; unsigned v = 0u;
            if (s <= t) { const unsigned bits = __float_as_uint(srow[s]); v = (bits & 0x80000000u) ? ~bits : (bits | 0x80000000u); }
            u[i] = v; }
        unsigned T = 0u;
        for (int bit = 31; bit >= 0; --bit) {
            const unsigned cand = T | (1u << bit); int cnt = 0;
#pragma unroll
            for (int i = 0; i < 32; ++i) cnt += (u[i] >= cand) ? 1 : 0;
            cnt = wave_sum_i(cnt);
            if (cnt >= TOPK) { T = cand; if (cnt == TOPK) break; }
        }
        int cgt = 0;
#pragma unroll
        for (int i = 0; i < 32; ++i) cgt += (u[i] > T) ? 1 : 0;
        cgt = wave_sum_i(cgt);
        const int need = TOPK - cgt; int run = 0;
        const unsigned long long lt = (lane == 0) ? 0ull : ((~0ull) >> (64 - lane));
#pragma unroll
        for (int i = 0; i < 32; ++i) {
            const bool gt = u[i] > T, eq = u[i] == T;
            const unsigned long long eqb = __ballot(eq);
            const int pre = run + __popcll(eqb & lt);
            const unsigned long long w = __ballot(gt || (eq && pre < need));
            run += __popcll(eqb);
            if (lane == 0) mrow[i] = w;
        }
    }
    __syncthreads();
}

template <int MODE>
__device__ __forceinline__ void attn32(const Params& P, int L, LAS unsigned char* lds, int b, int q0, int wave, int lane) {
    const unsigned char* qkv = P.ws + WS_QKV;
    const f16* Q = (const f16*)(qkv + (MODE ? O_QB : O_QA)); const f16* K = (const f16*)(qkv + (MODE ? O_KB : O_KA)); const f16* V = (const f16*)(qkv + (MODE ? O_VB : O_VA));
    f16* Y = (f16*)(qkv + O_Y);
    const int tok0 = b * SEQ + q0, r = lane & 31, h = lane >> 5, head = wave, kvh = wave >> 2, tid = wave * 64 + lane;
    LAS float* wsf = (LAS float*)(lds + OFF_WSF) + wave * 32;
    const LAS unsigned long long* msk = (const LAS unsigned long long*)(lds + OFF_MSK);
    f16x8 qf[4];
    { const f16* qp = Q + (size_t)(tok0 + r) * 512 + head * 64 + 8 * h;
#pragma unroll
      for (int s = 0; s < 4; ++s) qf[s] = *(const f16x8*)(qp + 16 * s); }
    const int kt1 = (q0 + 31) / 64, kt0 = MODE ? 0 : ((q0 - 127 > 0 ? q0 - 127 : 0) / 64);
    float m = MODE ? NEG : P.sinks[L * 8 + head] * LOG2E, lsum = (MODE == 0 && h == 0) ? 1.0f : 0.f;
    f32x16 o0 = {}, o1 = {};
    const int row0 = tid >> 4, part = tid & 15;
    const int ldso = (part >> 3) * KV_HEAD + row0 * RS + (part & 7) * 16;
    const f16* kg = K + (size_t)(b * SEQ + row0) * 128 + part * 8; const f16* vg = V + (size_t)(b * SEQ + row0) * 128 + part * 8;
    u32x4 kr0, kr1, vr0, vr1;
#define MIX_LOAD(kt) do { const size_t go = (size_t)(kt) * 64 * 128; kr0 = *(const u32x4*)(kg + go); kr1 = *(const u32x4*)(kg + go + 32 * 128); vr0 = *(const u32x4*)(vg + go); vr1 = *(const u32x4*)(vg + go + 32 * 128); } while (0)
#define MIX_STORE(st) do { LAS unsigned char* sb = lds + OFF_KV + (st) * KV_STAGE + ldso; *(LAS u32x4*)sb = kr0; *(LAS u32x4*)(sb + 32 * RS) = kr1; *(LAS u32x4*)(sb + 2 * KV_HEAD) = vr0; *(LAS u32x4*)(sb + 2 * KV_HEAD + 32 * RS) = vr1; } while (0)
    MIX_LOAD(kt0); MIX_STORE(0);
    __syncthreads();
    const int trq = (lane & 15) >> 2, trp = lane & 3, trc = (lane >> 4) & 1;
    for (int kt = kt0; kt <= kt1; ++kt) {
        const int cur = (kt - kt0) & 1;
        if (kt < kt1) MIX_LOAD(kt + 1);
        const LAS unsigned char* kb_ = lds + OFF_KV + cur * KV_STAGE + kvh * KV_HEAD; const LAS unsigned char* vb_ = kb_ + 2 * KV_HEAD;
        f32x16 p0 = {}, p1 = {};
#pragma unroll
        for (int s = 0; s < 4; ++s) {
            const f16x8 k0 = *(const LAS f16x8*)(kb_ + r * RS + (16 * s + 8 * h) * 2), k1 = *(const LAS f16x8*)(kb_ + (32 + r) * RS + (16 * s + 8 * h) * 2);
            p0 = __builtin_amdgcn_mfma_f32_32x32x16_f16(k0, qf[s], p0, 0, 0, 0); p1 = __builtin_amdgcn_mfma_f32_32x32x16_f16(k1, qf[s], p1, 0, 0, 0);
        }
        unsigned long long w;
        if (MODE) w = msk[r * 32 + kt];
        else { const int t = q0 + r; int lo = t - 127 - 64 * kt, hi = t - 64 * kt;
            if (hi < 0 || lo > 63) w = 0ull; else { lo = lo < 0 ? 0 : lo; hi = hi > 63 ? 63 : hi; w = ((~0ull) << lo) & ((~0ull) >> (63 - hi)); } }
        const unsigned w0 = (unsigned)w >> (4 * h), w1 = (unsigned)(w >> 32) >> (4 * h);
        float mt = NEG;
#pragma unroll
        for (int g = 0; g < 16; ++g) { const int c = (g & 3) + 8 * (g >> 2);
            mt = ((w0 >> c) & 1u) ? fmaxf(mt, p0[g]) : mt; mt = ((w1 >> c) & 1u) ? fmaxf(mt, p1[g]) : mt; }
        mt = swap_max(mt);
        const float mn = fmaxf(m, mt), alpha = __builtin_amdgcn_exp2f(m - mn); m = mn;
        float ps = 0.f;
#pragma unroll
        for (int g = 0; g < 16; ++g) { const int c = (g & 3) + 8 * (g >> 2);
            p0[g] = ((w0 >> c) & 1u) ? __builtin_amdgcn_exp2f(p0[g] - mn) : 0.f; p1[g] = ((w1 >> c) & 1u) ? __builtin_amdgcn_exp2f(p1[g] - mn) : 0.f; ps += p0[g] + p1[g]; }
        lsum = lsum * alpha + ps;
        if (h == 0) wsf[r] = alpha;
#pragma unroll
        for (int g4 = 0; g4 < 4; ++g4) { const f32x4 a4 = *(const LAS f32x4*)(wsf + 8 * g4 + 4 * h);
#pragma unroll
            for (int i = 0; i < 4; ++i) { o0[4 * g4 + i] *= a4[i]; o1[4 * g4 + i] *= a4[i]; } }
#pragma unroll
        for (int kb = 0; kb < 2; ++kb)
#pragma unroll
            for (int s2 = 0; s2 < 2; ++s2) {
                f16x8 pa;
#pragma unroll
                for (int j = 0; j < 8; ++j) pa[j] = (f16)(kb ? p1[8 * s2 + j] : p0[8 * s2 + j]);
                const LAS unsigned char* vrow = vb_ + (32 * kb + 16 * s2 + 4 * h + trq) * RS + (16 * trc + 4 * trp) * 2;
#pragma unroll
                for (int db = 0; db < 2; ++db) {
                    const s16x4 lo4 = __builtin_amdgcn_ds_read_tr16_b64_v4i16((LAS s16x4*)(vrow + db * 64));
                    const s16x4 hi4 = __builtin_amdgcn_ds_read_tr16_b64_v4i16((LAS s16x4*)(vrow + db * 64 + 8 * RS));
                    const f16x8 vf = __builtin_bit_cast(f16x8, __builtin_shufflevector(lo4, hi4, 0, 1, 2, 3, 4, 5, 6, 7));
                    if (db == 0) o0 = __builtin_amdgcn_mfma_f32_32x32x16_f16(pa, vf, o0, 0, 0, 0); else o1 = __builtin_amdgcn_mfma_f32_32x32x16_f16(pa, vf, o1, 0, 0, 0);
                }
            }
        if (kt < kt1) MIX_STORE(cur ^ 1);
        __syncthreads();
    }
#undef MIX_LOAD
#undef MIX_STORE
    { const float lt = swap_sum(lsum); if (h == 0) wsf[r] = 1.0f / lt; }
    LAS float* stg = (LAS float*)(lds + OFF_KV);
#pragma unroll
    for (int g4 = 0; g4 < 4; ++g4) { const f32x4 a4 = *(const LAS f32x4*)(wsf + 8 * g4 + 4 * h);
#pragma unroll
        for (int i = 0; i < 4; ++i) { const int q = 8 * g4 + 4 * h + i; stg[q * STG_LD + head * 64 + r] = o0[4 * g4 + i] * a4[i]; stg[q * STG_LD + head * 64 + 32 + r] = o1[4 * g4 + i] * a4[i]; } }
    __syncthreads();
#pragma unroll
    for (int qq = 0; qq < 4; ++qq) { const int q = 4 * wave + qq;
        const f32x4 v0 = *(const LAS f32x4*)(stg + q * STG_LD + lane * 8), v1 = *(const LAS f32x4*)(stg + q * STG_LD + lane * 8 + 4);
        float ss = (v0[0] * v0[0] + v0[1] * v0[1]) + (v0[2] * v0[2] + v0[3] * v0[3]) + (v1[0] * v1[0] + v1[1] * v1[1]) + (v1[2] * v1[2] + v1[3] * v1[3]);
        ss = wave_sum(ss);
        const float rr = 1.0f / sqrtf(ss * (1.0f / 512.0f) + 1e-6f);
        f16x8 o; o[0] = (f16)(v0[0] * rr); o[1] = (f16)(v0[1] * rr); o[2] = (f16)(v0[2] * rr); o[3] = (f16)(v0[3] * rr); o[4] = (f16)(v1[0] * rr); o[5] = (f16)(v1[1] * rr); o[6] = (f16)(v1[2] * rr); o[7] = (f16)(v1[3] * rr);
        *(f16x8*)(Y + (size_t)(tok0 + q) * DM + MODE * 512 + lane * 8) = o; }
    __syncthreads();
}

__device__ __forceinline__ void phase_mixer(const Params& P, int L, LAS unsigned char* lds, const int wave_s) {
    const int lane = TIDX(wave_s) & 63, wave = wave_s;
    for (int c = blockIdx.x; c < 256; c += gridDim.x) {
        const int b = c >> 5, qa = c & 31;
        for (int half = 0; half < 2; ++half) {
            const int q0 = 32 * (half ? 63 - qa : qa);
            select16(P, lds, b, q0, 0, wave, lane);
            select16(P, lds, b, q0 + 16, 16, wave, lane);
            attn32<0>(P, L, lds, b, q0, wave, lane);
            attn32<1>(P, L, lds, b, q0, wave, lane);
        }
    }
}
}

__device__ __forceinline__ void phase_ln(const Params& P, const float* g, const float* bta, const float* mod_next  , const int wave_s) {
    const int lane = TIDX(wave_s) & 63, wave = wave_s; f16* H = (f16*)(P.ws + WS_H);
    for (int row = blockIdx.x * 8 + wave; row < MTOK; row += gridDim.x * 8) {
        float* xr = P.out + (size_t)row * DM; const int b = row / SEQ;
        f32x4 v[4]; float s = 0.f;
#pragma unroll
        for (int j = 0; j < 4; ++j) { v[j] = *(const f32x4*)(xr + j * 256 + lane * 4); s += (v[j][0] + v[j][1]) + (v[j][2] + v[j][3]); }
        const float mean = wave_sum(s) * (1.0f / DM); float s2 = 0.f;
#pragma unroll
        for (int j = 0; j < 4; ++j) { v[j] = v[j] - mean; s2 += (v[j][0] * v[j][0] + v[j][1] * v[j][1]) + (v[j][2] * v[j][2] + v[j][3] * v[j][3]); }
        const float rstd = 1.0f / sqrtf(wave_sum(s2) * (1.0f / DM) + 1e-5f);
#pragma unroll
        for (int j = 0; j < 4; ++j) { const int col = j * 256 + lane * 4;
            const f32x4 gg = *(const f32x4*)(g + col), bb = *(const f32x4*)(bta + col);
            const f32x4 xo = v[j] * rstd * gg + bb;
            *(f32x4*)(xr + col) = xo;
            if (mod_next) { const f32x4 sh = *(const f32x4*)(mod_next + (size_t)b * 6 * DM + col), sc = *(const f32x4*)(mod_next + (size_t)b * 6 * DM + DM + col);
                *(f16x4*)(H + (size_t)row * DM + col) = cvt4(xo * (sc + 1.0f) + sh); } }
    }
}

#define XB_TMO      128
#define XB_XCNT(j)  (256  + 64 * (j))
#define XB_XSUB(j)  (1280 + 64 * (j))
#define XB_XGEN(j)  (2304 + 64 * (j))
#define XB_TOP      3328
#define XB_TOPGEN   3392
#define XCD_BAR_WORDS 3456
#define XB_SPIN_CAP (1u << 20)
__device__ __forceinline__ unsigned xb_ld(unsigned* p)              { return __hip_atomic_load(p, __ATOMIC_RELAXED, __HIP_MEMORY_SCOPE_AGENT); }
__device__ __forceinline__ unsigned xb_add(unsigned* p, unsigned v) { return __hip_atomic_fetch_add(p, v, __ATOMIC_RELAXED, __HIP_MEMORY_SCOPE_AGENT); }
__device__ __forceinline__ unsigned xb_xcc_id() { return (unsigned)__builtin_amdgcn_s_getreg((3 << 11) | 20) & 0xFu; }
#define XB_SPIN(cond, bar) do { unsigned _sp = 0; while (cond) { __builtin_amdgcn_s_sleep(1); \
    if ((++_sp & 255u) == 0u) { if (xb_ld(&(bar)[XB_TMO])) break; if (_sp > XB_SPIN_CAP) { atomicAdd(&(bar)[XB_TMO], 1u); break; } } } } while (0)
struct XcdBarrier { unsigned* bar; unsigned x; volatile LAS unsigned* st; };
__device__ __forceinline__ XcdBarrier xcd_barrier_post(unsigned* bar, volatile LAS unsigned* st, int tid) {
    XcdBarrier b; b.bar = bar; b.x = xb_xcc_id(); b.st = st;
    if (tid == 0) (void)xb_add(&bar[XB_XCNT(b.x)], 1u);
    return b;
}
__device__ __forceinline__ void xcd_barrier_complete(unsigned* bar, unsigned x, unsigned& nloc, unsigned& nx) {
    const unsigned G = gridDim.x * gridDim.y * gridDim.z;
    unsigned sum, cnt, mine, sp = 0u;
    for (;;) {
        sum = 0u; cnt = 0u; mine = 0u;
#pragma unroll
        for (unsigned j = 0; j < 16; ++j) { const unsigned c = xb_ld(&bar[XB_XCNT(j)]); sum += c; cnt += (c > 0u) ? 1u : 0u; mine = (j == x) ? c : mine; }
        if (sum == G) break;
        __builtin_amdgcn_s_sleep(1);
        if ((++sp & 255u) == 0u) { if (xb_ld(&bar[XB_TMO])) break; if (sp > XB_SPIN_CAP) { atomicAdd(&bar[XB_TMO], 1u); break; } }
    }
    nloc = mine > 0u ? mine : 1u; nx = cnt > 0u ? cnt : 1u;
}
__device__ __forceinline__ void xcd_barrier(const XcdBarrier& b, int tid) {
    asm volatile("s_waitcnt vmcnt(0)" ::: "memory");
    __syncthreads();
    if (tid == 0) {
        unsigned* bar = b.bar;
        __builtin_amdgcn_s_waitcnt(0);
        unsigned nloc = b.st[0], nx = b.st[1];
        if (nloc == 0u) { xcd_barrier_complete(bar, b.x, nloc, nx); b.st[0] = nloc; b.st[1] = nx; }
        const unsigned old = xb_add(&bar[XB_XSUB(b.x)], 1u);
        const unsigned gen = old / nloc;
        if (old + 1u == (gen + 1u) * nloc) {
            __builtin_amdgcn_fence(__ATOMIC_RELEASE, "agent");
            asm volatile("s_waitcnt vmcnt(0)" ::: "memory");
            const unsigned og = xb_add(&bar[XB_TOP], 1u);
            const unsigned tg = og / nx;
            if (og + 1u == (tg + 1u) * nx) xb_add(&bar[XB_TOPGEN], 1u);
            else XB_SPIN(xb_ld(&bar[XB_TOPGEN]) == tg, bar);
            __builtin_amdgcn_fence(__ATOMIC_ACQUIRE, "agent");
            xb_add(&bar[XB_XGEN(b.x)], 1u);
            asm volatile("s_waitcnt vmcnt(0)" ::: "memory");
        } else {
            XB_SPIN(xb_ld(&bar[XB_XGEN(b.x)]) == gen, bar);
            __builtin_amdgcn_fence(__ATOMIC_ACQUIRE, "agent");
            asm volatile("s_waitcnt vmcnt(0)" ::: "memory");
        }
    }
    __syncthreads();
}
constexpr int LDS_MISC = LDS_BYTES - 64;
constexpr size_t CTL_BAR_BYTES = 16384;

template <int L, int SUB>
__device__ __forceinline__ void layer_phase(const Params& P, LAS unsigned char* lds, const int wave_s) {
    const int G = gridDim.x;
    unsigned char* ws = P.ws; unsigned char* qkv = ws + WS_QKV;
    unsigned char* wb = ws + WS_W + (size_t)L * W_LAYER;
    const float* modl = (const float*)(ws + WS_MOD) + (size_t)L * BATCH * 6 * DM;
    if constexpr (SUB == 0) {
        pg8::Gemm g{(const h16_t*)(ws + WS_H), (const h16_t*)(wb + W_IN), MTOK, NINP, DM}; pg8::StaticOrder S; S.init(MTOK, NINP, G, (int)blockIdx.x);
        EpiRope E{(f16*)(qkv + O_QA), (f16*)(qkv + O_KA), (f16*)(qkv + O_VA), (f16*)(qkv + O_QB), (f16*)(qkv + O_KB), (f16*)(qkv + O_VB), (f16*)(qkv + O_QI), (f16*)(qkv + O_KI), (float*)(qkv + O_WI), (const float*)(ws + WS_ROPE)};
        pg8::gemm_phase<EpiRope, pg8::StaticOrder, true, true>(lds, g, S, E, wave_s);
    } else if constexpr (SUB == 1) {
#if MK_NAIVE_ATTN
        phase_swa_naive(P, L, wave_s); phase_select_naive(P, lds, wave_s);
#else
        mix::phase_mixer(P, L, lds, wave_s);
#endif
    } else if constexpr (SUB == 2) {
#if MK_NAIVE_ATTN
        phase_dsa_naive(P, wave_s);
#endif
    }
    else if constexpr (SUB == 3) {
        pg8::Gemm g{(const h16_t*)(qkv + O_Y), (const h16_t*)(wb + W_O), MTOK, DM, DM}; pg8::StaticOrder S; S.init(MTOK, DM, G, (int)blockIdx.x);
        EpiResid E{L == 0 ? P.x : P.out, P.out, modl + 2 * DM};
        pg8::gemm_phase<EpiResid, pg8::StaticOrder, true, true>(lds, g, S, E, wave_s);
    } else if constexpr (SUB == 4) phase_ln(P, P.ln1_g + L * DM, P.ln1_b + L * DM, modl + 3 * DM, wave_s);
    else if constexpr (SUB == 5) {
        pg8::Gemm g{(const h16_t*)(ws + WS_H), (const h16_t*)(wb + W_GU), MTOK, NGU, DM}; pg8::StaticOrder S; S.init(MTOK, NGU, G, (int)blockIdx.x);
        EpiSwiglu E{(f16*)qkv};
        pg8::gemm_phase<EpiSwiglu, pg8::StaticOrder, true, true>(lds, g, S, E, wave_s);
    } else if constexpr (SUB == 6) {
        pg8::Gemm g{(const h16_t*)qkv, (const h16_t*)(wb + W_D), MTOK, DM, DFF}; pg8::StaticOrder S; S.init(MTOK, DM, G, (int)blockIdx.x);
        EpiResid E{P.out, P.out, modl + 5 * DM};
        pg8::gemm_phase<EpiResid, pg8::StaticOrder, true, true>(lds, g, S, E, wave_s);
    } else phase_ln(P, P.ln2_g + L * DM, P.ln2_b + L * DM, (L + 1 < DEPTH) ? (modl + BATCH * 6 * DM) : nullptr, wave_s);
}

__global__ void __launch_bounds__(512, 2) mk_fwd(Params P) {
    extern __shared__ __attribute__((aligned(16))) unsigned char lds_raw[];
    LAS unsigned char* lds = (LAS unsigned char*)lds_raw;
    const int lo = P.ph_lo, hi = P.ph_hi, use_cg = P.use_cg;
    const int wave_s = __builtin_amdgcn_readfirstlane(threadIdx.x >> 6);
    if (use_cg == 2) {
        if (threadIdx.x < 2) ((volatile LAS unsigned*)(lds + LDS_MISC))[threadIdx.x] = 0u;
        __syncthreads();
        (void)xcd_barrier_post((unsigned*)(P.ws + WS_CTL), (volatile LAS unsigned*)(lds + LDS_MISC), (int)threadIdx.x);
    }
    typedef const __attribute__((address_space(4))) Params* CParams;
#if defined(__HIP_DEVICE_COMPILE__)
#define FRESH() CParams pp_ = (CParams)__builtin_amdgcn_kernarg_segment_ptr(); asm volatile("" : "+s"(pp_)); const Params Pl = *pp_;
#else
#define FRESH() const Params Pl = P;
#endif
#define IN(k) (lo <= (k) && (k) < hi)
#define SEAM(k) do { if (IN((k) + 1)) { if (use_cg == 1) { CG_SYNC(); } else if (use_cg == 2) { FRESH(); XcdBarrier bar_; bar_.bar = (unsigned*)(Pl.ws + WS_CTL); bar_.x = xb_xcc_id(); bar_.st = (volatile LAS unsigned*)(lds + LDS_MISC); xcd_barrier(bar_, TIDX(wave_s)); } } __syncthreads(); } while (0)
#define LPH(L, SUB) if (IN(2 + 8 * (L) + (SUB))) { { FRESH(); layer_phase<L, SUB>(Pl, lds, wave_s); } SEAM(2 + 8 * (L) + (SUB)); }
    if (IN(0)) { { FRESH(); phase_prep(Pl, lds, wave_s); } SEAM(0); }
    if (IN(1)) { { FRESH(); phase_h0(Pl, wave_s); } SEAM(1); }
    LPH(0, 0) LPH(0, 1) LPH(0, 2) LPH(0, 3) LPH(0, 4) LPH(0, 5) LPH(0, 6) LPH(0, 7)
    LPH(1, 0) LPH(1, 1) LPH(1, 2) LPH(1, 3) LPH(1, 4) LPH(1, 5) LPH(1, 6) LPH(1, 7)
#undef IN
#undef SEAM
#undef LPH
}

#ifndef MK_CHECK
#define MK_CHECK 0
#define MK_CHECK_LAYER 0
#define MK_CHECK_BASE 0
#endif
#if MK_CHECK
__device__ __forceinline__ void flag_max(float* f, float err) { if (!(err == err)) err = 1e30f; atomicMax((int*)f, __float_as_int(err)); }
__device__ __forceinline__ int samp_tok(int j) { return (int)(((long)j * 5231 + 1777) % MTOK); }
__global__ void chk_mod(Params P, float* flags) {
    const int j = blockIdx.x * blockDim.x + threadIdx.x; if (j >= 512) return;
    const int l = j & 1, b = (j >> 1) & 7, n = ((j >> 4) * 197 + 13) % (6 * DM);
    float ref = P.b_ada[l * 6 * DM + n];
    for (int k = 0; k < DM; ++k) { const float v = P.c[b * DM + k]; ref += (v / (1.0f + expf(-v))) * P.w_ada[((size_t)l * DM + k) * 6 * DM + n]; }
    const float got = ((const float*)(P.ws + WS_MOD))[((size_t)l * BATCH + b) * 6 * DM + n];
    flag_max(flags + 0, fabsf(ref - got) / (fabsf(ref) + 0.02f));
}
__global__ void chk_inproj(Params P, float* flags, int L) {
    const int j = blockIdx.x * blockDim.x + threadIdx.x; if (j >= 32 * 34 * 2) return;
    const int tok = samp_tok(j / 68), r = j % 68, hb = r >> 1, dd = (r & 1) ? 21 : 3, b = tok / SEQ;
    const float* mod = (const float*)(P.ws + WS_MOD) + ((size_t)L * BATCH + b) * 6 * DM;
    const float* w = P.w_in + (size_t)L * DM * NIN;
    const float* xr = (L == 0 ? P.x : P.out) + (size_t)tok * DM;
    const unsigned char* qkv = P.ws + WS_QKV;
    if (hb == 33) {
        const int c = 2112 + (dd == 3 ? 1 : 6); float a = 0.f;
        for (int k = 0; k < DM; ++k) { const float h = (float)(f16)(xr[k] * (1.0f + mod[DM + k]) + mod[k]); a += h * (float)(f16)w[(size_t)k * NIN + c]; }
        const float got = ((const float*)(qkv + O_WI))[(size_t)tok * 8 + (c - 2112)];
        flag_max(flags + 1, fabsf(a - got) / (fabsf(a) + 0.05f)); return;
    }
    const int c = hb * 64 + dd; float a1 = 0.f, a2 = 0.f;
    for (int k = 0; k < DM; ++k) { const float h = (float)(f16)(xr[k] * (1.0f + mod[DM + k]) + mod[k]); a1 += h * (float)(f16)w[(size_t)k * NIN + c]; a2 += h * (float)(f16)w[(size_t)k * NIN + c + 32]; }
    const f16* dst; int pitch, col; bool rope = true; float sc = 1.f;
    if (hb < 8) { dst = (const f16*)(qkv + O_QA); pitch = 512; col = hb * 64; sc = QSCALE; }
    else if (hb < 10) { dst = (const f16*)(qkv + O_KA); pitch = 128; col = (hb - 8) * 64; }
    else if (hb < 12) { dst = (const f16*)(qkv + O_VA); pitch = 128; col = (hb - 10) * 64; rope = false; }
    else if (hb < 20) { dst = (const f16*)(qkv + O_QB); pitch = 512; col = (hb - 12) * 64; sc = QSCALE; }
    else if (hb < 22) { dst = (const f16*)(qkv + O_KB); pitch = 128; col = (hb - 20) * 64; }
    else if (hb < 24) { dst = (const f16*)(qkv + O_VB); pitch = 128; col = (hb - 22) * 64; rope = false; }
    else if (hb < 32) { dst = (const f16*)(qkv + O_QI); pitch = 512; col = (hb - 24) * 64; }
    else { dst = (const f16*)(qkv + O_KI); pitch = 64; col = 0; }
    float o1 = a1, o2 = a2;
    if (rope) { const float inv = powf(10000.0f, -(float)dd / 32.0f); const float ang = (float)P.pos[tok] * inv; const float cs = (float)cos((double)ang), sn = (float)sin((double)ang);
        o1 = (a1 * cs - a2 * sn) * sc; o2 = (a2 * cs + a1 * sn) * sc; }
    const float g1 = (float)dst[(size_t)tok * pitch + col + dd], g2 = (float)dst[(size_t)tok * pitch + col + dd + 32];
    flag_max(flags + 1, fabsf(o1 - g1) / (fabsf(o1) + 0.05f)); flag_max(flags + 1, fabsf(o2 - g2) / (fabsf(o2) + 0.05f));
}
__global__ void chk_swa(Params P, float* flags, int L) {
    __shared__ float sc[8][128]; __shared__ float red[512]; __shared__ float den[8];
    const int tok = samp_tok(blockIdx.x * 7 + 3), t = tok % SEQ, b = tok / SEQ, tid = threadIdx.x, h = tid >> 6, d = tid & 63, kvh = h >> 2;
    const unsigned char* qkv = P.ws + WS_QKV;
    const f16* QA = (const f16*)(qkv + O_QA); const f16* KA = (const f16*)(qkv + O_KA); const f16* VA = (const f16*)(qkv + O_VA); const f16* Y = (const f16*)(qkv + O_Y);
    const int s0 = t - 127 < 0 ? 0 : t - 127, nk = t - s0 + 1;
    for (int i = d; i < nk; i += 64) { float a = 0.f; for (int e = 0; e < 64; ++e) a += (float)QA[(size_t)tok * 512 + h * 64 + e] * (float)KA[((size_t)(b * SEQ + s0 + i)) * 128 + kvh * 64 + e]; sc[h][i] = a; }
    __syncthreads();
    if (d == 0) { float m = P.sinks[L * 8 + h] * LOG2E; for (int i = 0; i < nk; ++i) m = fmaxf(m, sc[h][i]); float dn = exp2f(P.sinks[L * 8 + h] * LOG2E - m); for (int i = 0; i < nk; ++i) { const float p = exp2f(sc[h][i] - m); sc[h][i] = p; dn += p; } den[h] = dn; }
    __syncthreads();
    float o = 0.f; for (int i = 0; i < nk; ++i) o += sc[h][i] * (float)VA[((size_t)(b * SEQ + s0 + i)) * 128 + kvh * 64 + d];
    o /= den[h]; red[tid] = o * o; __syncthreads();
    for (int st = 256; st > 0; st >>= 1) { if (tid < st) red[tid] += red[tid + st]; __syncthreads(); }
    const float ref = o / sqrtf(red[0] / 512.0f + 1e-6f), got = (float)Y[(size_t)tok * DM + h * 64 + d];
    flag_max(flags + 2, fabsf(ref - got) / (fabsf(ref) + 0.1f));
}
__global__ void chk_dsa(Params P, float* flags) {
    __shared__ float ssc[2048]; __shared__ unsigned char sel[2048]; __shared__ float red[512]; __shared__ float pm[8], dn[8]; __shared__ float diff[512];
    const int tok = samp_tok(blockIdx.x * 61 + 5), t = tok % SEQ, b = tok / SEQ, tid = threadIdx.x, h = tid >> 6, d = tid & 63, kvh = h >> 2;
    const unsigned char* qkv = P.ws + WS_QKV;
    const f16* QB = (const f16*)(qkv + O_QB); const f16* KB = (const f16*)(qkv + O_KB); const f16* VB = (const f16*)(qkv + O_VB); const f16* Y = (const f16*)(qkv + O_Y);
    const f16* QI = (const f16*)(qkv + O_QI); const f16* KI = (const f16*)(qkv + O_KI); const float* WI = (const float*)(qkv + O_WI);
    for (int s = tid; s <= t; s += 512) { float tot = 0.f;
        for (int hh = 0; hh < 8; ++hh) { float a = 0.f; for (int e = 0; e < 64; ++e) a += (float)QI[(size_t)tok * 512 + hh * 64 + e] * (float)KI[((size_t)(b * SEQ + s)) * 64 + e]; tot += WI[(size_t)tok * 8 + hh] * fmaxf(a, 0.f); }
        ssc[s] = tot + 0.0f; }
    __syncthreads();
    for (int s = tid; s <= t; s += 512) { int rank = 0; const float v = ssc[s]; for (int i = 0; i <= t; ++i) { const float w = ssc[i]; rank += (w > v || (w == v && i < s)) ? 1 : 0; } sel[s] = rank < TOPK ? 1 : 0; }
    __syncthreads();
    float o = 0.f;
    for (int hh = 0; hh < 8; ++hh) {
        __syncthreads();
        for (int s = tid; s <= t; s += 512) { float a = -INFINITY; if (sel[s]) { a = 0.f; for (int e = 0; e < 64; ++e) a += (float)QB[(size_t)tok * 512 + hh * 64 + e] * (float)KB[((size_t)(b * SEQ + s)) * 128 + (hh >> 2) * 64 + e]; } ssc[s] = a; }
        __syncthreads();
        if (tid == 0) { float m = -INFINITY; for (int s = 0; s <= t; ++s) m = fmaxf(m, ssc[s]); float dd = 0.f; for (int s = 0; s <= t; ++s) dd += exp2f(ssc[s] - m); pm[hh] = m; dn[hh] = dd; }
        __syncthreads();
        if (h == hh) { float acc = 0.f; for (int s = 0; s <= t; ++s) if (sel[s]) acc += exp2f(ssc[s] - pm[hh]) * (float)VB[((size_t)(b * SEQ + s)) * 128 + kvh * 64 + d]; o = acc / dn[hh]; }
    }
    __syncthreads();
    red[tid] = o * o; __syncthreads();
    for (int st = 256; st > 0; st >>= 1) { if (tid < st) red[tid] += red[tid + st]; __syncthreads(); }
    const float ref = o / sqrtf(red[0] / 512.0f + 1e-6f), got = (float)Y[(size_t)tok * DM + 512 + h * 64 + d];
    __syncthreads();
    diff[tid] = (ref - got) * (ref - got); __syncthreads();
    for (int st = 256; st > 0; st >>= 1) { if (tid < st) diff[tid] += diff[tid + st]; __syncthreads(); }
    if (tid == 0) flag_max(flags + 3, sqrtf(diff[0] / 512.0f));
}
__global__ void chk_resid(Params P, float* flags, int L, int which  , const float* xin_saved) {
    const int j = blockIdx.x * blockDim.x + threadIdx.x; if (j >= 1024) return;
    const int tok = samp_tok(j >> 4), n = ((j & 15) * 67 + 5) % DM, b = tok / SEQ;
    const float* mod = (const float*)(P.ws + WS_MOD) + ((size_t)L * BATCH + b) * 6 * DM;
    float a = 0.f;
    if (which == 0) { const f16* Y = (const f16*)(P.ws + WS_QKV + O_Y); const float* w = P.w_o + (size_t)L * DM * DM;
        for (int k = 0; k < DM; ++k) { const float g = k < 512 ? P.g_a[L * 512 + k] : P.g_b[L * 512 + k - 512]; a += (float)Y[(size_t)tok * DM + k] * (float)(f16)(g * w[(size_t)k * DM + n]); } }
    else { const f16* A = (const f16*)(P.ws + WS_QKV); const float* w = P.w_down + (size_t)L * DFF * DM;
        for (int k = 0; k < DFF; ++k) a += (float)A[(size_t)tok * DFF + k] * (float)(f16)w[(size_t)k * DM + n]; }
    const float ref = ALPHA * xin_saved[(j >> 4) * DM + n] + (1.0f + mod[(which ? 5 : 2) * DM + n]) * a, got = P.out[(size_t)tok * DM + n];
    flag_max(flags + (which ? 6 : 4), fabsf(ref - got) / (fabsf(ref) + 0.1f));
}
__global__ void chk_save_rows(const float* src, float* dst) {
    const int r = blockIdx.x; const int tok = samp_tok(r); for (int i = threadIdx.x; i < DM; i += blockDim.x) dst[r * DM + i] = src[(size_t)tok * DM + i];
}
__global__ void chk_act(Params P, float* flags, int L) {
    const int j = blockIdx.x * blockDim.x + threadIdx.x; if (j >= 1024) return;
    const int tok = samp_tok(j >> 4), f = ((j & 15) * 173 + 9) % DFF;
    const f16* H = (const f16*)(P.ws + WS_H); const float* wg = P.w_gate + (size_t)L * DM * DFF; const float* wu = P.w_up + (size_t)L * DM * DFF;
    float g = 0.f, u = 0.f; for (int k = 0; k < DM; ++k) { const float h = (float)H[(size_t)tok * DM + k]; g += h * (float)(f16)wg[(size_t)k * DFF + f]; u += h * (float)(f16)wu[(size_t)k * DFF + f]; }
    const float ref = g / (1.0f + expf(-g)) * u, got = (float)((const f16*)(P.ws + WS_QKV))[(size_t)tok * DFF + f];
    flag_max(flags + 5, fabsf(ref - got) / (fabsf(ref) + 0.05f));
}
__global__ void chk_ln(Params P, float* flags, const float* pre_saved, const float* g, const float* bta, const float* mod_next_l  , int shidx) {
    __shared__ float red[256];
    const int r = blockIdx.x, tok = samp_tok(r), b = tok / SEQ, tid = threadIdx.x;
    float s = 0.f; for (int i = tid; i < DM; i += 256) s += pre_saved[r * DM + i]; red[tid] = s; __syncthreads();
    for (int st = 128; st > 0; st >>= 1) { if (tid < st) red[tid] += red[tid + st]; __syncthreads(); }
    const float mean = red[0] / DM; __syncthreads();
    float q = 0.f; for (int i = tid; i < DM; i += 256) { const float dlt = pre_saved[r * DM + i] - mean; q += dlt * dlt; } red[tid] = q; __syncthreads();
    for (int st = 128; st > 0; st >>= 1) { if (tid < st) red[tid] += red[tid + st]; __syncthreads(); }
    const float rstd = 1.0f / sqrtf(red[0] / DM + 1e-5f);
    for (int i = tid; i < DM; i += 256) { const float ref = (pre_saved[r * DM + i] - mean) * rstd * g[i] + bta[i]; const float got = P.out[(size_t)tok * DM + i];
        flag_max(flags + 7, fabsf(ref - got) / (fabsf(ref) + 0.1f));
        if (mod_next_l) { const float* mb = mod_next_l + (size_t)b * 6 * DM; const float hr = ref * (1.0f + mb[(shidx + 1) * DM + i]) + mb[shidx * DM + i]; const float hg = (float)((const f16*)(P.ws + WS_H))[(size_t)tok * DM + i];
            flag_max(flags + 7, fabsf(hr - hg) / (fabsf(hr) + 0.1f)); } }
}
__global__ void chk_encode(float* out, const float* flags, int base, float t0, float t1, float t2, float t3) {
    const float th[4] = {t0, t1, t2, t3}; int z = 0;
    for (int k = 0; k < 4; ++k) if (flags[base + k] > th[k]) z |= (8 >> k);
    for (size_t i = (size_t)blockIdx.x * blockDim.x + threadIdx.x; i < (size_t)MTOK * DM; i += (size_t)gridDim.x * blockDim.x) if ((int)(i & 15) < z) out[i] = 0.f;
}
#endif

#ifndef MK_ONE_LAUNCH
#define MK_ONE_LAUNCH 1
#endif
extern "C" void kernel_launch(void* const* d_in, const int* in_sizes, int n_in, void* d_out, int out_size, void* d_ws, size_t ws_size, hipStream_t stream) {
    static int grid = 0;
    if (grid == 0) {
        if (n_in != 17 || out_size != MTOK * DM || ws_size < WS_END) { fprintf(stderr, "kernel_launch: unexpected shapes (n_in %d out %d ws %zu)\n", n_in, out_size, ws_size); grid = -1; return; }
        int dev = 0, cus = 0, per_cu = 0;
        hipGetDevice(&dev); hipDeviceGetAttribute(&cus, hipDeviceAttributeMultiprocessorCount, dev);
        hipFuncSetAttribute((const void*)mk_fwd, hipFuncAttributeMaxDynamicSharedMemorySize, LDS_BYTES);
        hipOccupancyMaxActiveBlocksPerMultiprocessor(&per_cu, (const void*)mk_fwd, 512, LDS_BYTES);
        if (per_cu < 1) { fprintf(stderr, "kernel_launch: occupancy query says %d blocks per CU\n", per_cu); per_cu = 1; }
        (void)hipGetLastError();
        grid = cus;
    }
    if (grid < 0) return;
    Params p{};
    p.x = (const float*)d_in[0]; p.c = (const float*)d_in[1]; p.pos = (const int*)d_in[2]; p.w_ada = (const float*)d_in[3]; p.b_ada = (const float*)d_in[4]; p.w_in = (const float*)d_in[5];
    p.sinks = (const float*)d_in[6]; p.g_a = (const float*)d_in[7]; p.g_b = (const float*)d_in[8]; p.w_o = (const float*)d_in[9]; p.ln1_g = (const float*)d_in[10]; p.ln1_b = (const float*)d_in[11];
    p.w_gate = (const float*)d_in[12]; p.w_up = (const float*)d_in[13]; p.w_down = (const float*)d_in[14]; p.ln2_g = (const float*)d_in[15]; p.ln2_b = (const float*)d_in[16];
    p.out = (float*)d_out; p.ws = (unsigned char*)d_ws;
#if MK_ONE_LAUNCH
    p.ph_lo = 0; p.ph_hi = NPHASE; p.use_cg = MK_BARRIER;
    (void)hipMemsetAsync((char*)d_ws + WS_CTL, 0, CTL_BAR_BYTES, stream);
    void* args[] = {&p};
    hipError_t e = hipLaunchCooperativeKernel((const void*)mk_fwd, dim3(grid), dim3(512), args, LDS_BYTES, stream);
    if (e != hipSuccess) fprintf(stderr, "cooperative launch failed: %s (grid %d)\n", hipGetErrorString(e), grid);
#else
#if MK_CHECK
    float* flags = (float*)((char*)d_ws + WS_CTL); float* save0 = (float*)((char*)d_ws + WS_CTL + 4096); float* save1 = save0 + 64 * DM;
    (void)hipMemsetAsync(flags, 0, 4096, stream);
    const int CL = MK_CHECK_LAYER;
#endif
    for (int ph = 0; ph < NPHASE; ++ph) {
        p.ph_lo = ph; p.ph_hi = ph + 1; p.use_cg = 0;
#if MK_CHECK
        const int cl = (ph - 2) >> 3, cs = (ph - 2) & 7;
        if (ph >= 2 && cl == CL && cs == 0 && CL == 0) {}
        if (ph >= 2 && cl == CL && cs == 3) hipLaunchKernelGGL(chk_save_rows, dim3(64), dim3(256), 0, stream, (const float*)(CL == 0 ? p.x : p.out), save0);
        if (ph >= 2 && cl == CL && cs == 6) hipLaunchKernelGGL(chk_save_rows, dim3(64), dim3(256), 0, stream, (const float*)p.out, save0);
#endif
        hipLaunchKernelGGL(mk_fwd, dim3(grid), dim3(512), LDS_BYTES, stream, p);
#if MK_CHECK
        if (ph == 0) hipLaunchKernelGGL(chk_mod, dim3(2), dim3(256), 0, stream, p, flags);
        if (ph >= 2 && cl == CL) {
            if (cs == 0 && CL == 0) hipLaunchKernelGGL(chk_inproj, dim3(9), dim3(256), 0, stream, p, flags, CL);
            if (cs == 1) hipLaunchKernelGGL(chk_swa, dim3(24), dim3(512), 0, stream, p, flags, CL);
            if (cs == 2) hipLaunchKernelGGL(chk_dsa, dim3(24), dim3(512), 0, stream, p, flags);
            if (cs == 3) { hipLaunchKernelGGL(chk_resid, dim3(4), dim3(256), 0, stream, p, flags, CL, 0, (const float*)save0); hipLaunchKernelGGL(chk_save_rows, dim3(64), dim3(256), 0, stream, (const float*)p.out, save1); }
            if (cs == 4) hipLaunchKernelGGL(chk_ln, dim3(64), dim3(256), 0, stream, p, flags, (const float*)save1, p.ln1_g + CL * DM, p.ln1_b + CL * DM, (const float*)((char*)d_ws + WS_MOD) + (size_t)CL * BATCH * 6 * DM, 3);
            if (cs == 5) hipLaunchKernelGGL(chk_act, dim3(4), dim3(256), 0, stream, p, flags, CL);
            if (cs == 6) hipLaunchKernelGGL(chk_resid, dim3(4), dim3(256), 0, stream, p, flags, CL, 1, (const float*)save0);
        }
#endif
    }
#if MK_CHECK
    hipLaunchKernelGGL(chk_encode, dim3(1024), dim3(256), 0, stream, (float*)d_out, (const float*)flags, MK_CHECK_BASE, MK_CHECK_BASE == 0 ? 0.02f : 0.03f, 0.03f, MK_CHECK_BASE == 0 ? 0.05f : 0.03f, MK_CHECK_BASE == 0 ? 0.3f : 0.03f);
#endif
#endif
}
```
